# Optimizing an MI355X kernel written in HIP

```python
import jax, jax.numpy as jnp
from jax import lax
import numpy as np

D_MODEL = 2048
BATCH = 16
SEQ = 2048
DEPTH = 2

GRID_W = 64
CTX_LEN = 256
N_MIXERS = 2
N_HEADS = 16
N_KV_HEADS = 4
HEAD_DIM = D_MODEL // N_HEADS
GROUP = N_HEADS // N_KV_HEADS
WINDOW = 128
BLOCK = 128
ROPE_BASE = 10000.0
GLA_HEADS = 4
GLA_KD = D_MODEL // 2
GLA_VD = D_MODEL
GLA_DK = GLA_KD // GLA_HEADS
GLA_DV = GLA_VD // GLA_HEADS
GLA_GATE_RANK = 16
GLA_TAU = 16.0
GLA_CHUNK = 64
MOE_GROUPS = 4
MOE_EXPERTS_PER_GROUP = 8
N_EXPERTS = MOE_GROUPS * MOE_EXPERTS_PER_GROUP
MOE_TOP_K = 2
MOE_HIDDEN = D_MODEL // 4
LN_EPS = 1e-5
RMS_EPS = 1e-6

kernel_name = "hybrid_swa_gla_hiermoe_dit"


def layer_norm(x, g, b):
    xf = x.astype(jnp.float32)
    mu = jnp.mean(xf, axis=-1, keepdims=True)
    var = jnp.mean(jnp.square(xf - mu), axis=-1, keepdims=True)
    return ((xf - mu) * lax.rsqrt(var + LN_EPS) * g + b).astype(x.dtype)


def adaln_mods(cond, w, b):
    m = (jax.nn.silu(cond) @ w + b)[:, None, :]
    return jnp.split(m, 6, axis=-1)


def axial_rope(x, ang_row, ang_col):
    def rot(z, ang):
        z1, z2 = jnp.split(z, 2, axis=-1)
        cos = jnp.cos(ang)[None, :, None, :].astype(z.dtype)
        sin = jnp.sin(ang)[None, :, None, :].astype(z.dtype)
        return jnp.concatenate([z1 * cos - z2 * sin, z2 * cos + z1 * sin], axis=-1)
    xr, xc = jnp.split(x, 2, axis=-1)
    return jnp.concatenate([rot(xr, ang_row), rot(xc, ang_col)], axis=-1)


def windowed_gqa(h, hc, w_qkv, w_o, sink, with_ctx_out):
    B, T, _ = h.shape
    C = hc.shape[1]
    HQ = N_HEADS * HEAD_DIM
    HKV = N_KV_HEADS * HEAD_DIM
    scale = HEAD_DIM ** -0.5
    q, k, v = jnp.split(h @ w_qkv, [HQ, HQ + HKV], axis=-1)
    q = q.reshape(B, T, N_HEADS, HEAD_DIM)
    k = k.reshape(B, T, N_KV_HEADS, HEAD_DIM)
    v = v.reshape(B, T, N_KV_HEADS, HEAD_DIM)
    rows = T // GRID_W
    row, col = jnp.meshgrid(jnp.arange(rows), jnp.arange(GRID_W), indexing="ij")
    half = HEAD_DIM // 2
    inv_freq = ROPE_BASE ** (-jnp.arange(0, half, 2, dtype=jnp.float32) / half)
    ang_row = row.reshape(-1).astype(jnp.float32)[:, None] * inv_freq
    ang_col = col.reshape(-1).astype(jnp.float32)[:, None] * inv_freq
    q = axial_rope(q, ang_row, ang_col)
    k = axial_rope(k, ang_row, ang_col)
    kc, vc = jnp.split(hc @ w_qkv[:, HQ:], 2, axis=-1)
    kc = kc.reshape(B, C, N_KV_HEADS, HEAD_DIM)
    vc = vc.reshape(B, C, N_KV_HEADS, HEAD_DIM)
    nblk = T // BLOCK
    pad = ((0, 0), (BLOCK, BLOCK), (0, 0), (0, 0))
    kp, vp = jnp.pad(k, pad), jnp.pad(v, pad)
    kb = jnp.concatenate([kp[:, j * BLOCK:j * BLOCK + T].reshape(B, nblk, BLOCK, N_KV_HEADS, HEAD_DIM) for j in range(3)], axis=2)
    vb = jnp.concatenate([vp[:, j * BLOCK:j * BLOCK + T].reshape(B, nblk, BLOCK, N_KV_HEADS, HEAD_DIM) for j in range(3)], axis=2)
    a_idx = jnp.arange(BLOCK)[:, None]
    s_idx = jnp.arange(3 * BLOCK)[None, :]
    rel = s_idx - BLOCK - a_idx
    key_pos = jnp.arange(nblk)[:, None, None] * BLOCK - BLOCK + s_idx[None]
    mask = (jnp.abs(rel) <= WINDOW)[None] & (key_pos >= 0) & (key_pos < T)
    qb = q.reshape(B, nblk, BLOCK, N_KV_HEADS, GROUP, HEAD_DIM)
    s_win = jnp.einsum("bnqkgd,bnskd->bkgnqs", qb, kb).astype(jnp.float32) * scale
    s_win = jnp.where(mask, s_win, -jnp.inf)
    s_ctx = jnp.einsum("bnqkgd,bckd->bkgnqc", qb, kc).astype(jnp.float32) * scale
    sink_f = sink.astype(jnp.float32).reshape(1, N_KV_HEADS, GROUP, 1, 1, 1)
    sink_col = jnp.broadcast_to(sink_f, s_win.shape[:-1] + (1,))
    p = jax.nn.softmax(jnp.concatenate([s_win, s_ctx, sink_col], axis=-1), axis=-1).astype(v.dtype)
    p_win, p_ctx = p[..., :3 * BLOCK], p[..., 3 * BLOCK:3 * BLOCK + C]
    o = jnp.einsum("bkgnqs,bnskd->bnqkgd", p_win, vb) + jnp.einsum("bkgnqc,bckd->bnqkgd", p_ctx, vc)
    y = o.reshape(B, T, HQ) @ w_o
    if not with_ctx_out:
        return y, None
    qc = (hc @ w_qkv[:, :HQ]).reshape(B, C, N_KV_HEADS, GROUP, HEAD_DIM)
    sc = jnp.einsum("bqkgd,bckd->bkgqc", qc, kc).astype(jnp.float32) * scale
    sink_c = jnp.broadcast_to(sink_f[..., 0], sc.shape[:-1] + (1,))
    pc = jax.nn.softmax(jnp.concatenate([sc, sink_c], axis=-1), axis=-1)[..., :C].astype(vc.dtype)
    oc = jnp.einsum("bkgqc,bckd->bqkgd", pc, vc)
    yc = oc.reshape(B, C, HQ) @ w_o
    return y, yc


def gla_chunk_scan(q, k, v, lg, s0, with_out):
    B, H, T, _ = k.shape
    n = T // GLA_CHUNK
    to_chunks = lambda t: jnp.moveaxis(t.reshape(B, H, n, GLA_CHUNK, t.shape[-1]), 2, 0)
    tril = jnp.tril(jnp.ones((GLA_CHUNK, GLA_CHUNK), dtype=bool))

    def step(S, inp):
        kc, vc, gc = inp[0], inp[1], inp[2]
        b = jnp.cumsum(gc, axis=-2)
        b_last = b[..., -1:, :]
        S_new = jnp.exp(b_last[..., 0, :])[..., None] * S + jnp.einsum("bhsd,bhsv->bhdv", kc * jnp.exp(b_last - b), vc)
        if not with_out:
            return S_new, None
        qc = inp[3]
        diff = jnp.where(tril[:, :, None], b[..., :, None, :] - b[..., None, :, :], -jnp.inf)
        att = jnp.einsum("bhtd,bhsd,bhtsd->bhts", qc, kc, jnp.exp(diff))
        o = jnp.einsum("bhts,bhsv->bhtv", att, vc) + jnp.einsum("bhtd,bhdv->bhtv", qc * jnp.exp(b), S)
        return S_new, o

    xs = (to_chunks(k), to_chunks(v), to_chunks(lg)) + ((to_chunks(q),) if with_out else ())
    S_fin, o = lax.scan(step, s0, xs)
    if with_out:
        o = jnp.moveaxis(o, 0, 2).reshape(B, H, T, -1)
    return o, S_fin


def gla_bidir(q, k, v, lg_f, lg_b, s0_f, s0_b, with_out):
    flip = lambda t: None if t is None else jnp.flip(t, axis=2)
    o_f, s_f = gla_chunk_scan(q, k, v, lg_f, s0_f, with_out)
    o_b, s_b = gla_chunk_scan(flip(q), flip(k), flip(v), flip(lg_b), s0_b, with_out)
    o = o_f + jnp.flip(o_b, axis=2) if with_out else None
    return o, s_f, s_b


def bidir_gla(h, hc, w_in, gate_w1, gate_w2, gate_b, norm_g, w_o, with_ctx_out):
    def project(z, with_out):
        B, T, _ = z.shape
        heads = lambda t, d: t.reshape(B, T, GLA_HEADS, d).transpose(0, 2, 1, 3).astype(jnp.float32)
        k = heads(z @ w_in[:, GLA_KD:2 * GLA_KD], GLA_DK)
        v = heads(z @ w_in[:, 2 * GLA_KD:2 * GLA_KD + GLA_VD], GLA_DV)
        lg_f, lg_b = (heads(jax.nn.log_sigmoid((z @ gate_w1[d] @ gate_w2[d] + gate_b[d]).astype(jnp.float32)) / GLA_TAU, GLA_DK) for d in range(2))
        if not with_out:
            return None, k, v, lg_f, lg_b, None
        q = heads(z @ w_in[:, :GLA_KD], GLA_DK) * (GLA_DK ** -0.5)
        r = z @ w_in[:, 2 * GLA_KD + GLA_VD:]
        return q, k, v, lg_f, lg_b, r

    def readout(o, r):
        B, _, T, _ = o.shape
        o = o.transpose(0, 2, 1, 3)
        o = o * lax.rsqrt(jnp.mean(jnp.square(o), axis=-1, keepdims=True) + RMS_EPS) * norm_g
        return (o.reshape(B, T, GLA_VD).astype(r.dtype) * jax.nn.silu(r)) @ w_o

    B = h.shape[0]
    zeros = jnp.zeros((B, GLA_HEADS, GLA_DK, GLA_DV), jnp.float32)
    qc, kc, vc, gfc, gbc, rc = project(hc, with_ctx_out)
    oc, s_f, s_b = gla_bidir(qc, kc, vc, gfc, gbc, zeros, zeros, with_ctx_out)
    q, k, v, gf, gb, r = project(h, True)
    o, _, _ = gla_bidir(q, k, v, gf, gb, s_f, s_b, True)
    y = readout(o, r)
    yc = readout(oc, rc) if with_ctx_out else None
    return y, yc


def hier_moe(h, wg, bg, we, be, w_gate, w_up, w_down):
    g_logits = (h @ wg + bg).astype(jnp.float32)
    g_prob = jax.nn.softmax(g_logits, axis=-1)
    g_idx = jnp.argmax(g_logits, axis=-1)
    g_w = jnp.take_along_axis(g_prob, g_idx[:, None], axis=-1)
    e_logits = (h @ we + be).astype(jnp.float32).reshape(-1, MOE_GROUPS, MOE_EXPERTS_PER_GROUP)
    e_in = jnp.take_along_axis(e_logits, g_idx[:, None, None], axis=1)[:, 0]
    top_v, top_i = lax.top_k(e_in, MOE_TOP_K)
    e_w = jax.nn.softmax(top_v, axis=-1) * g_w
    expert_id = g_idx[:, None] * MOE_EXPERTS_PER_GROUP + top_i
    combine = jnp.sum(jax.nn.one_hot(expert_id, N_EXPERTS, dtype=jnp.float32) * e_w[..., None], axis=1).astype(h.dtype)
    out = jnp.zeros_like(h)
    for e in range(N_EXPERTS):
        hid = jax.nn.silu(h @ w_gate[e]) * (h @ w_up[e])
        out = out + combine[:, e:e + 1] * (hid @ w_down[e])
    return out


def setup_inputs(seed: int = 0) -> dict:
    key = jax.random.key(seed)
    ks = iter(jax.random.split(key, 40))
    f32 = jnp.float32
    nrm = lambda shape, s: jax.random.normal(next(ks), shape, f32) * s
    beta = (8 * DEPTH) ** -0.25
    NA = (DEPTH + 1) // 2
    NB = DEPTH // 2
    D = D_MODEL
    return {
        "x": nrm((BATCH, SEQ, D), 1.0),
        "c": nrm((BATCH, D), 1.0),
        "ctx": nrm((BATCH, CTX_LEN, D), 1.0),
        "c_ctx": nrm((D,), 1.0),
        "mod_w": nrm((DEPTH, D, 6 * D), D ** -0.5),
        "mod_b": nrm((DEPTH, 6 * D), 0.02),
        "ln_g": 1.0 + nrm((DEPTH, 2, D), 0.02),
        "ln_b": nrm((DEPTH, 2, D), 0.02),
        "attn_w_qkv": nrm((NA, D, (N_HEADS + 2 * N_KV_HEADS) * HEAD_DIM), D ** -0.5),
        "attn_w_o": nrm((NA, N_HEADS * HEAD_DIM, D), (N_HEADS * HEAD_DIM) ** -0.5 * beta),
        "attn_sink": nrm((NA, N_HEADS), 0.5),
        "gla_w_in": nrm((NB, D, 2 * GLA_KD + 2 * GLA_VD), D ** -0.5),
        "gla_gate_w1": nrm((NB, 2, D, GLA_GATE_RANK), D ** -0.5),
        "gla_gate_w2": nrm((NB, 2, GLA_GATE_RANK, GLA_KD), GLA_GATE_RANK ** -0.5),
        "gla_gate_b": nrm((NB, 2, GLA_KD), 0.1),
        "gla_norm_g": 1.0 + nrm((NB, GLA_DV), 0.02),
        "gla_w_o": nrm((NB, GLA_VD, D), GLA_VD ** -0.5 * beta),
        "moe_group_w": nrm((DEPTH, D, MOE_GROUPS), D ** -0.5),
        "moe_group_b": nrm((DEPTH, MOE_GROUPS), 0.01),
        "moe_router_w": nrm((DEPTH, D, N_EXPERTS), D ** -0.5),
        "moe_router_b": nrm((DEPTH, N_EXPERTS), 0.01),
        "moe_w_gate": nrm((DEPTH, N_EXPERTS, D, MOE_HIDDEN), D ** -0.5),
        "moe_w_up": nrm((DEPTH, N_EXPERTS, D, MOE_HIDDEN), D ** -0.5),
        "moe_w_down": nrm((DEPTH, N_EXPERTS, MOE_HIDDEN, D), MOE_HIDDEN ** -0.5 * beta),
    }


def reference(x, c, ctx, c_ctx, mod_w, mod_b, ln_g, ln_b, attn_w_qkv, attn_w_o, attn_sink,
              gla_w_in, gla_gate_w1, gla_gate_w2, gla_gate_b, gla_norm_g, gla_w_o,
              moe_group_w, moe_group_b, moe_router_w, moe_router_b, moe_w_gate, moe_w_up, moe_w_down):
    alpha = (2 * DEPTH) ** 0.25
    B, T, D = x.shape
    xc = ctx
    for l in range(DEPTH):
        last = l == DEPTH - 1
        j = l // N_MIXERS
        sh1, sc1, g1, sh2, sc2, g2 = adaln_mods(c, mod_w[l], mod_b[l])
        csh1, csc1, cg1, csh2, csc2, cg2 = adaln_mods(c_ctx[None], mod_w[l], mod_b[l])
        h = x * (1 + sc1) + sh1
        hc = xc * (1 + csc1) + csh1
        if l % N_MIXERS == 0:
            y, yc = windowed_gqa(h, hc, attn_w_qkv[j], attn_w_o[j], attn_sink[j], not last)
        else:
            y, yc = bidir_gla(h, hc, gla_w_in[j], gla_gate_w1[j], gla_gate_w2[j], gla_gate_b[j],
                              gla_norm_g[j], gla_w_o[j], not last)
        x = layer_norm(alpha * x + g1 * y, ln_g[l, 0], ln_b[l, 0])
        if last:
            f = hier_moe((x * (1 + sc2) + sh2).reshape(-1, D), moe_group_w[l], moe_group_b[l],
                         moe_router_w[l], moe_router_b[l], moe_w_gate[l], moe_w_up[l], moe_w_down[l])
            x = layer_norm(alpha * x + g2 * f.reshape(B, T, D), ln_g[l, 1], ln_b[l, 1])
        else:
            xc = layer_norm(alpha * xc + cg1 * yc, ln_g[l, 0], ln_b[l, 0])
            tokens = jnp.concatenate([(x * (1 + sc2) + sh2).reshape(-1, D),
                                      (xc * (1 + csc2) + csh2).reshape(-1, D)], axis=0)
            f = hier_moe(tokens, moe_group_w[l], moe_group_b[l], moe_router_w[l], moe_router_b[l],
                         moe_w_gate[l], moe_w_up[l], moe_w_down[l])
            x = layer_norm(alpha * x + g2 * f[:B * T].reshape(B, T, D), ln_g[l, 1], ln_b[l, 1])
            xc = layer_norm(alpha * xc + cg2 * f[B * T:].reshape(xc.shape), ln_g[l, 1], ln_b[l, 1])
    return x
```

```cpp
#include <hip/hip_runtime.h>
#include <cstdio>
#include <cstdint>

#ifndef MK_FUSED
#define MK_FUSED 1
#endif
#ifndef MK_CHECK
#define MK_CHECK 0
#endif

#define GAS __attribute__((address_space(1)))
#define LAS __attribute__((address_space(3)))
typedef unsigned short bf16;
typedef short bf16x8 __attribute__((ext_vector_type(8)));
typedef short s16x4 __attribute__((ext_vector_type(4)));
typedef float f32x2 __attribute__((ext_vector_type(2)));
typedef float f32x4 __attribute__((ext_vector_type(4)));
typedef float f32x16 __attribute__((ext_vector_type(16)));
typedef unsigned u32x2 __attribute__((ext_vector_type(2)));
typedef unsigned u32x4 __attribute__((ext_vector_type(4)));
typedef __bf16 bf16x2_t __attribute__((ext_vector_type(2)));
typedef short v4i16_t __attribute__((ext_vector_type(4)));

constexpr int DM = 2048, NBATCH = 16, SEQ = 2048, CTXL = 256;
constexpr int ML = NBATCH * SEQ, MC = NBATCH * CTXL, MA = ML + MC;
constexpr int NQKV = 3072, NPROJ = 6400, MODN = 6 * DM, NEXP = 32, MOEH = 512;
constexpr int HD = 128, NHEAD = 16, NKV = 4;
constexpr int GLAH = 4, GDK = 256, GDV = 512;
constexpr float ALPHA = 1.41421356237309515f;
constexpr float LN_EPS = 1e-5f, RMS_EPS = 1e-6f;
constexpr float LOG2E = 1.4426950408889634f;
constexpr float QSCALE = 0.08838834764831845f * LOG2E;

constexpr size_t MiB = 1u << 20;
constexpr size_t WS_CTL = 0, CTL_ZERO_BYTES = 8 * 1024;
constexpr size_t WS_MODS = 1 * MiB;
constexpr size_t WS_ROPE = 3 * MiB;
constexpr size_t WS_WQKV = 4 * MiB, WS_WO = 16 * MiB, WS_WIN = 24 * MiB, WS_WO2 = 50 * MiB, WS_WR = 58 * MiB;
constexpr size_t WS_WGU = 60 * MiB, WS_WD = 188 * MiB;
constexpr size_t WS_VX = 252 * MiB;
constexpr size_t WS_HB = 540 * MiB;
constexpr size_t WS_R1 = 684 * MiB;
constexpr size_t WS_Q = WS_R1, WS_K = WS_R1 + 144 * MiB, WS_V = WS_R1 + 180 * MiB, WS_O = WS_R1 + 216 * MiB;
constexpr size_t WS_GQ = WS_R1, WS_GK = WS_R1 + 64 * MiB, WS_A2 = WS_R1, WS_GV = WS_R1 + 136 * MiB, WS_GR = WS_R1 + 280 * MiB, WS_GU = WS_R1 + 408 * MiB, WS_OB = WS_R1 + 413 * MiB;
constexpr size_t WS_LOG = WS_R1, WS_LIST = WS_R1 + 36 * MiB, WS_WLIST = WS_R1 + 45 * MiB, WS_HID = WS_R1 + 56 * MiB, WS_Y2 = WS_R1 + 136 * MiB;
constexpr size_t WS_END = WS_R1 + 541 * MiB;
constexpr int LISTCAP = 2 * MA;
constexpr int CW_TMO = 0, CW_CODE = 1;
constexpr int CW_BAR = 32;
constexpr int CW_STRIDE = 16;
constexpr int CW_CNT = 704;
constexpr int CW_WQ = 704 + 64 * 16;
static_assert((CW_WQ + 32) * 4 <= (int)CTL_ZERO_BYTES, "control words");

constexpr int RING_BYTES = 131072;
constexpr int MISC_OFF = 139264;
constexpr int LDS_BYTES = 147456;
constexpr int NWAVES = 8, NTHREADS = 512;

#define RLX_AGENT __ATOMIC_RELAXED, __HIP_MEMORY_SCOPE_AGENT
#define LDS_WAIT() asm volatile("s_waitcnt lgkmcnt(0)" ::: "memory")
#define VM_WAIT() asm volatile("s_waitcnt vmcnt(0)" ::: "memory")

__device__ __forceinline__ unsigned cvtpk(float lo, float hi) { f32x2 v = {lo, hi}; bf16x2_t b = __builtin_convertvector(v, bf16x2_t); return __builtin_bit_cast(unsigned, b); }
__device__ __forceinline__ float bf2f(unsigned short b) { return __uint_as_float(((unsigned)b) << 16); }
__device__ __forceinline__ float bflo(unsigned w) { return __uint_as_float(w << 16); }
__device__ __forceinline__ float bfhi(unsigned w) { return __uint_as_float(w & 0xffff0000u); }
__device__ __forceinline__ unsigned short f2bf(float f) { return (unsigned short)(cvtpk(f, 0.f) & 0xffffu); }
__device__ __forceinline__ float fexp2(float x) { return __builtin_amdgcn_exp2f(x); }
__device__ __forceinline__ float frcp(float x) { return __builtin_amdgcn_rcpf(x); }
__device__ __forceinline__ float silu_f(float x) { return x * frcp(1.f + fexp2(-x * LOG2E)); }
__device__ __forceinline__ float wave_sum(float v) {
#pragma unroll
    for (int o = 1; o < 64; o <<= 1) v += __shfl_xor(v, o);
    return v;
}
__device__ __forceinline__ int lane_id() { return (int)__builtin_amdgcn_mbcnt_hi(~0u, __builtin_amdgcn_mbcnt_lo(~0u, 0u)); }
__device__ __forceinline__ int lane_id_v() { int l; asm volatile("v_mbcnt_lo_u32_b32 %0, -1, 0\n\tv_mbcnt_hi_u32_b32 %0, -1, %0" : "=v"(l)); return l; }
__device__ __forceinline__ int crow(int r, int hi) { return (r & 3) + 8 * (r >> 2) + 4 * hi; }
__device__ __forceinline__ s16x4 tr_read(const LAS void* p) { return __builtin_bit_cast(s16x4, __builtin_amdgcn_ds_read_tr16_b64_v4i16((LAS v4i16_t*)p)); }
__device__ __forceinline__ bf16x8 cat8(s16x4 a, s16x4 b) { return __builtin_shufflevector(a, b, 0, 1, 2, 3, 4, 5, 6, 7); }
#define MFMA32(a, b, c) __builtin_amdgcn_mfma_f32_32x32x16_bf16((a), (b), (c), 0, 0, 0)
#define MFMA16(a, b, c) __builtin_amdgcn_mfma_f32_16x16x32_bf16((a), (b), (c), 0, 0, 0)

#define XB_TMO      0
#define XB_XCNT(j)  (32   + (j))
#define XB_XSUB(j)  (64   + 32 * (j))
#define XB_TOP      576
#define XB_TOPGEN   608
#define XCD_BAR_WORDS 640
#define XB_SPIN_CAP (1u << 18)
__device__ __forceinline__ unsigned xb_ld(unsigned* p)              { return __hip_atomic_load(p, __ATOMIC_RELAXED, __HIP_MEMORY_SCOPE_AGENT); }
__device__ __forceinline__ unsigned xb_add(unsigned* p, unsigned v) { return __hip_atomic_fetch_add(p, v, __ATOMIC_RELAXED, __HIP_MEMORY_SCOPE_AGENT); }
__device__ __forceinline__ unsigned xb_xcc_id() { return (unsigned)__builtin_amdgcn_s_getreg((3 << 11) | 20) & 0xFu; }
#define XB_SPIN(cond, bar) do { unsigned _sp = 0; while (cond) { __builtin_amdgcn_s_sleep(1); \
    if ((++_sp & 255u) == 0u) { if (xb_ld(&(bar)[XB_TMO])) break; if (_sp > XB_SPIN_CAP) { atomicAdd(&(bar)[XB_TMO], 1u); break; } } } } while (0)
struct XcdBarrier { unsigned* bar; unsigned x; volatile LAS unsigned* st; };
__device__ __forceinline__ XcdBarrier xcd_barrier_post(unsigned* bar, volatile LAS unsigned* st, int tid) {
    XcdBarrier b; b.bar = bar; b.x = xb_xcc_id(); b.st = st;
    if (tid == 0) (void)xb_add(&bar[XB_XCNT(b.x)], 1u);
    return b;
}
__device__ __forceinline__ void xcd_barrier_complete(unsigned* bar, unsigned x, unsigned& nloc, unsigned& nx) {
    const unsigned G = gridDim.x * gridDim.y * gridDim.z;
    unsigned sum, cnt, mine, sp = 0u;
    for (;;) {
        sum = 0u; cnt = 0u; mine = 0u;
#pragma unroll
        for (unsigned j = 0; j < 16; ++j) { const unsigned c = xb_ld(&bar[XB_XCNT(j)]); sum += c; cnt += (c > 0u) ? 1u : 0u; mine = (j == x) ? c : mine; }
        if (sum == G) break;
        __builtin_amdgcn_s_sleep(1);
        if ((++sp & 255u) == 0u) { if (xb_ld(&bar[XB_TMO])) break; if (sp > XB_SPIN_CAP) { atomicAdd(&bar[XB_TMO], 1u); break; } }
    }
    nloc = mine > 0u ? mine : 1u; nx = cnt > 0u ? cnt : 1u;
}
__device__ __forceinline__ void xcd_barrier(const XcdBarrier& b, int tid) {
    asm volatile("s_waitcnt vmcnt(0)" ::: "memory");
    __syncthreads();
    if (tid == 0) {
        unsigned* bar = b.bar;
        __builtin_amdgcn_s_waitcnt(0);
        unsigned nloc = b.st[0], nx = b.st[1];
        if (nloc == 0u) { xcd_barrier_complete(bar, b.x, nloc, nx); b.st[0] = nloc; b.st[1] = nx; }
        const unsigned old = xb_add(&bar[XB_XSUB(b.x)], 1u);
        const unsigned gen = old / nloc;
        if (old + 1u == (gen + 1u) * nloc) {
            __builtin_amdgcn_fence(__ATOMIC_RELEASE, "agent");
            asm volatile("s_waitcnt vmcnt(0)" ::: "memory");
            const unsigned og = xb_add(&bar[XB_TOP], 1u);
            const unsigned tg = og / nx;
            __builtin_amdgcn_fence(__ATOMIC_ACQUIRE, "agent");
            if (og + 1u == (tg + 1u) * nx) xb_add(&bar[XB_TOPGEN], 1u);
            else XB_SPIN(xb_ld(&bar[XB_TOPGEN]) == tg, bar);
            asm volatile("s_waitcnt vmcnt(0)" ::: "memory");
        } else {
            __builtin_amdgcn_fence(__ATOMIC_ACQUIRE, "agent");
            XB_SPIN(xb_ld(&bar[XB_TOPGEN]) == gen, bar);
            asm volatile("s_waitcnt vmcnt(0)" ::: "memory");
        }
    }
    __syncthreads();
}

struct Args { const float* in[24]; float* out; unsigned char* ws; int ph_lo, ph_hi, li, pad; };
enum { I_X = 0, I_C, I_CTX, I_CCTX, I_MODW, I_MODB, I_LNG, I_LNB, I_WQKV, I_WOA, I_SINK, I_WIN, I_GW1, I_GW2, I_GB, I_NG, I_WOG, I_MGW, I_MGB, I_MRW, I_MRB, I_MWG, I_MWU, I_MWD };
struct InPtrs { const float* const* p; __device__ __forceinline__ const float* operator[](int i) const { return p[i]; } };
struct Frame {
    LAS unsigned char* lds;
    unsigned* ctl;
    int tid, lane, wave, vcu, G;
    InPtrs in; float* out; unsigned char* ws;
};
__device__ __forceinline__ const float* mods_ptr(const Frame& F, int l, int mr, int chunk) { return (const float*)(F.ws + WS_MODS) + ((size_t)(l * 17 + mr) * MODN + chunk * DM); }
__device__ __forceinline__ int mod_row(int m) { return m < ML ? (m >> 11) : 16; }
namespace pg8 {
constexpr int BM = 256, BK = 64, HALF = 128, HTB = HALF * BK * 2, STAGE_BYTES = 8 * HTB, NXCD = 8, WGM = 8;
__host__ __device__ __forceinline__ int lds_byte(int r, int c) { const int st = (r >> 4) * 2 + (c >> 5), rr = r & 15, cc = c & 31, ob = rr * 64 + cc * 2; return st * 1024 + (ob ^ (((ob >> 9) & 1) << 5)); }
__host__ __device__ __forceinline__ void stage_rc(int b, int& R, int& C) { const int st = b / 1024, sb = b % 1024, swz = sb ^ (((sb >> 9) & 1) << 5); R = (st >> 1) * 16 + swz / 64; C = (st & 1) * 32 + (swz % 64) / 2; }
__host__ __device__ __forceinline__ int perm32(int rho) { const int n = rho >> 4, i = rho & 15; return 8 * (i >> 2) + 4 * n + (i & 3); }

struct Unit { int pm, pn, e, lrow0, valid; };

struct StaticOrder {
    int nM, nN, nwg, G, c;
    __device__ void init(int nM_, int nN_, int G_, int c_) { nM = nM_; nN = nN_; nwg = nM * nN; G = G_; c = c_; }
    __device__ bool map(int i, int& pm, int& pn) const {
        const long L = (long)i * G + c; if (L >= nwg) return false;
        int wgid = (int)L; { const int q = nwg / NXCD, r = nwg % NXCD, xcd = wgid % NXCD, off = wgid / NXCD; wgid = (xcd < r ? xcd * (q + 1) : r * (q + 1) + (xcd - r) * q) + off; }
        const int nig = WGM * nN, gid = wgid / nig, fm = gid * WGM, gsz = (nM - fm) < WGM ? (nM - fm) : WGM;
        pm = fm + ((wgid % nig) % gsz); pn = (wgid % nig) / gsz; return true;
    }
};

template <class Epi, class Prob, bool ALIGN_EPI>
__device__ __forceinline__ void gemm_phase(LAS unsigned char* lds, const Prob& P, const Epi& E, int wave) {
    const int wid = wave, lane = lane_id(), tid = wid * 64 + lane, wr = wid >> 2, wc = wid & 3, fr = lane & 15, fq = lane >> 4;
    const int K = P.K, nt = K / BK;
    unsigned voffB[2][2];
#pragma unroll
    for (int i = 0; i < 2; ++i) { int R, C; stage_rc(tid * 16 + i * 8192, R, C); const int Rb = Epi::PERM ? ((R & ~31) + perm32(R & 31)) : R;
        voffB[0][i] = (unsigned)(Rb * K + C) * 2u; voffB[1][i] = (unsigned)((Rb + HALF) * K + C) * 2u; }
    const size_t kstep = (size_t)(BK * 2);
    const unsigned ldsw = (unsigned)wid * 1024u;
    const int aoff = lds_byte(wr * 64 + fr, fq * 8), boff = lds_byte(wc * 32 + fr, fq * 8);
#define PG8_SA(b, h) (((b) * 2 + (h)) * HTB)
#define PG8_SB(b, h) ((4 + (b) * 2 + (h)) * HTB)
#define PG8_STAGE(bufoff, gbase, v0, v1) do { \
        __builtin_amdgcn_global_load_lds((const unsigned*)((const char*)(gbase) + (v0)), (LAS unsigned*)(lds + (bufoff) + ldsw), 16, 0, 0); \
        __builtin_amdgcn_global_load_lds((const unsigned*)((const char*)(gbase) + (v1)), (LAS unsigned*)(lds + (bufoff) + ldsw + 8192), 16, 0, 0); } while (0)
#define PG8_LDA(dst, b, h) do { _Pragma("unroll") for (int m = 0; m < 4; ++m) _Pragma("unroll") for (int k = 0; k < 2; ++k) dst[m][k] = *(const LAS bf16x8*)(lds + PG8_SA(b, h) + aoff + m * 2048 + k * 1024); } while (0)
#define PG8_LDB(dst, b, h) do { _Pragma("unroll") for (int n = 0; n < 2; ++n) _Pragma("unroll") for (int k = 0; k < 2; ++k) dst[n][k] = *(const LAS bf16x8*)(lds + PG8_SB(b, h) + boff + n * 2048 + k * 1024); } while (0)
#define PG8_MMA(ai, bj, At, Bt) do { __builtin_amdgcn_s_setprio(1); _Pragma("unroll") for (int m = 0; m < 4; ++m) _Pragma("unroll") for (int n = 0; n < 2; ++n) _Pragma("unroll") for (int k = 0; k < 2; ++k) \
        acc[ai][bj][m][n] = __builtin_amdgcn_mfma_f32_16x16x32_bf16(Bt[n][k], At[m][k], acc[ai][bj][m][n], 0, 0, 0); __builtin_amdgcn_s_setprio(0); } while (0)
#define PG8_WAIT_V(n) asm volatile("s_waitcnt vmcnt(" #n ")" ::: "memory")
#define PG8_WAIT_L(n) asm volatile("s_waitcnt lgkmcnt(" #n ")" ::: "memory")
#define PG8_BAR __builtin_amdgcn_s_barrier()
#define PG8_SCHED __builtin_amdgcn_sched_barrier(0)
    Unit cur, nxt; int ui = 0;
    if (!P.next(0, cur)) return;
    f32x4 acc[2][2][4][2];
#pragma unroll
    for (int a = 0; a < 2; ++a)
#pragma unroll
        for (int b = 0; b < 2; ++b)
#pragma unroll
            for (int m = 0; m < 4; ++m)
#pragma unroll
                for (int n = 0; n < 2; ++n) acc[a][b][m][n] = (f32x4){0.f, 0.f, 0.f, 0.f};
    bf16x8 At[4][2], B0[2][2], B1[2][2];
    const char* cA; const char* nA; unsigned cva[2][2], nva[2][2];
    P.a_setup(cur, cA, cva, tid);
    const char* cB = P.b_base(cur); const char* nB;
    PG8_STAGE(PG8_SB(0, 0), cB, voffB[0][0], voffB[0][1]); PG8_STAGE(PG8_SB(0, 1), cB, voffB[1][0], voffB[1][1]); PG8_STAGE(PG8_SA(0, 0), cA, cva[0][0], cva[0][1]); PG8_STAGE(PG8_SA(0, 1), cA, cva[1][0], cva[1][1]);
    if (wr == 1) PG8_BAR;
    PG8_WAIT_V(2); PG8_BAR;
    PG8_STAGE(PG8_SB(1, 0), cB + kstep, voffB[0][0], voffB[0][1]); PG8_STAGE(PG8_SA(1, 0), cA + kstep, cva[0][0], cva[0][1]); PG8_STAGE(PG8_SB(1, 1), cB + kstep, voffB[1][0], voffB[1][1]);
    PG8_WAIT_V(6); PG8_BAR;
    for (;;) {
        const bool has_next = P.next(ui + 1, nxt);
        nA = cA; nB = cB;
        if constexpr (Prob::GATHER) {
#pragma unroll
        for (int h = 0; h < 2; ++h)
#pragma unroll
            for (int i = 0; i < 2; ++i) nva[h][i] = cva[h][i]; }
        for (int t = 0; t < nt; t += 2) {
            const bool last = (t == nt - 2);
            if (last && has_next) { if constexpr (Prob::GATHER) P.a_setup(nxt, nA, nva, tid); else nA = P.a_base(nxt); nB = P.b_base(nxt); }
            const char* a1 = cA + (size_t)(t + 1) * kstep;
            const char* a2 = last ? nA : cA + (size_t)(t + 2) * kstep; const char* b2 = last ? nB : cB + (size_t)(t + 2) * kstep;
            const char* a3 = a2 + kstep; const char* b3 = b2 + kstep;
            unsigned x00 = cva[0][0], x01 = cva[0][1], x10 = cva[1][0], x11 = cva[1][1];
            if constexpr (Prob::GATHER) { x00 = last ? nva[0][0] : x00; x01 = last ? nva[0][1] : x01; x10 = last ? nva[1][0] : x10; x11 = last ? nva[1][1] : x11; }
            PG8_LDB(B0, 0, 0); PG8_LDB(B1, 0, 1); PG8_SCHED; PG8_LDA(At, 0, 0); PG8_STAGE(PG8_SA(1, 1), a1, cva[1][0], cva[1][1]);
            PG8_WAIT_V(8); PG8_WAIT_L(0); PG8_BAR; PG8_MMA(0, 0, At, B0); PG8_MMA(0, 1, At, B1); PG8_BAR; PG8_SCHED;
            PG8_LDA(At, 0, 1); PG8_STAGE(PG8_SB(0, 0), b2, voffB[0][0], voffB[0][1]); PG8_STAGE(PG8_SB(0, 1), b2, voffB[1][0], voffB[1][1]); PG8_STAGE(PG8_SA(0, 0), a2, x00, x01);
            PG8_WAIT_V(8); PG8_WAIT_L(0); PG8_BAR; PG8_MMA(1, 0, At, B0); PG8_MMA(1, 1, At, B1); PG8_BAR; PG8_SCHED;
            PG8_LDB(B0, 1, 0); PG8_LDB(B1, 1, 1); PG8_SCHED; PG8_LDA(At, 1, 0); PG8_STAGE(PG8_SA(0, 1), a2, x10, x11);
            PG8_WAIT_V(8); PG8_WAIT_L(0); PG8_BAR; PG8_MMA(0, 0, At, B0); PG8_MMA(0, 1, At, B1); PG8_BAR; PG8_SCHED;
            PG8_LDA(At, 1, 1); PG8_STAGE(PG8_SB(1, 0), b3, voffB[0][0], voffB[0][1]); PG8_STAGE(PG8_SB(1, 1), b3, voffB[1][0], voffB[1][1]); PG8_STAGE(PG8_SA(1, 0), a3, x00, x01);
            PG8_WAIT_V(8); PG8_WAIT_L(0); PG8_BAR; PG8_MMA(1, 0, At, B0); PG8_MMA(1, 1, At, B1); PG8_BAR; PG8_SCHED;
        }
        if constexpr (ALIGN_EPI) { if (wr == 0) PG8_BAR; }
        E(acc, cur, wr, wc, fr, fq);
        if (!has_next) break;
#pragma unroll
        for (int a = 0; a < 2; ++a)
#pragma unroll
            for (int b = 0; b < 2; ++b)
#pragma unroll
                for (int m = 0; m < 4; ++m)
#pragma unroll
                    for (int n = 0; n < 2; ++n) acc[a][b][m][n] = (f32x4){0.f, 0.f, 0.f, 0.f};
        cur = nxt; cA = nA; cB = nB; ++ui;
        if constexpr (Prob::GATHER) {
#pragma unroll
        for (int h = 0; h < 2; ++h)
#pragma unroll
            for (int i = 0; i < 2; ++i) cva[h][i] = nva[h][i]; }
        if constexpr (ALIGN_EPI) { if (wr == 1) PG8_BAR; }
    }
    PG8_WAIT_V(0);
    if constexpr (!ALIGN_EPI) { if (wr == 0) PG8_BAR; }
    PG8_BAR;
#undef PG8_SA
#undef PG8_SB
#undef PG8_STAGE
#undef PG8_LDA
#undef PG8_LDB
#undef PG8_MMA
#undef PG8_WAIT_V
#undef PG8_WAIT_L
#undef PG8_BAR
#undef PG8_SCHED
}

__device__ __forceinline__ void dense_offsets(int K, unsigned (&va)[2][2], int tid) {
#pragma unroll
    for (int i = 0; i < 2; ++i) { int R, C; stage_rc(tid * 16 + i * 8192, R, C); va[0][i] = (unsigned)(R * K + C) * 2u; va[1][i] = (unsigned)((R + HALF) * K + C) * 2u; }
}
}
struct ProbDense {
    int K; const bf16* A; const bf16* Bt; pg8::StaticOrder S;
    __device__ __forceinline__ bool next(int i, pg8::Unit& u) const { u.e = 0; u.lrow0 = 0; u.valid = 256; return S.map(i, u.pm, u.pn); }
    static constexpr bool GATHER = false;
    __device__ __forceinline__ const char* a_base(const pg8::Unit& u) const { return (const char*)(A + (size_t)u.pm * 256 * K); }
    __device__ __forceinline__ void a_setup(const pg8::Unit& u, const char*& base, unsigned (&va)[2][2], int tid) const { base = a_base(u); pg8::dense_offsets(K, va, tid); }
    __device__ __forceinline__ const char* b_base(const pg8::Unit& u) const { return (const char*)(Bt + (size_t)u.pn * 256 * K); }
};

struct EpiQKV {
    static constexpr bool PERM = true;
    bf16* Q; bf16* Kb; bf16* Vb; const float* cs;
    __device__ __forceinline__ void operator()(const f32x4 (&acc)[2][2][4][2], const pg8::Unit& u, int wr, int wc, int fr_, int fq_) const {
        int fr = fr_, fq = fq_; asm volatile("" : "+v"(fr), "+v"(fq));
        const int row0 = u.pm * 256 + wr * 64 + fr;
        bf16* dst; int ldc, colt; float sc = 1.f; bool rope = (u.pm < ML / 256);
        if (u.pn < 8) { dst = Q; ldc = DM; colt = u.pn * 256; sc = QSCALE; }
        else if (u.pn < 10) { dst = Kb; ldc = 512; colt = (u.pn - 8) * 256; }
        else { dst = Vb; ldc = 512; colt = (u.pn - 10) * 256; rope = false; }
        const int p0 = wc * 32 + fq * 8;
        const int i0 = (p0 & 63) >> 1;
#pragma unroll
        for (int ai = 0; ai < 2; ++ai) {
            f32x4 ca[4], cb[4];
#pragma unroll
            for (int m = 0; m < 4; ++m) { const int row = row0 + ai * 128 + m * 16, t = row & (SEQ - 1), pos = (wc < 2) ? (t >> 6) : (t & 63);
                ca[m] = (f32x4){1.f, 0.f, 1.f, 0.f}; cb[m] = ca[m];
                if (rope) { const f32x4* cp = (const f32x4*)(cs + (size_t)(pos * 32 + i0) * 2); ca[m] = cp[0]; cb[m] = cp[1]; } }
#pragma unroll
            for (int m = 0; m < 4; ++m) {
                const int row = row0 + ai * 128 + m * 16;
                bf16* rowp = dst + (size_t)row * ldc + colt + wc * 32 + fq * 8;
#pragma unroll
                for (int bj = 0; bj < 2; ++bj) {
                    const f32x4 v0 = acc[ai][bj][m][0], v1 = acc[ai][bj][m][1];
                    const float o0 = (v0[0] * ca[m][0] - v0[1] * ca[m][1]) * sc, o1 = (v0[1] * ca[m][0] + v0[0] * ca[m][1]) * sc;
                    const float o2 = (v0[2] * ca[m][2] - v0[3] * ca[m][3]) * sc, o3 = (v0[3] * ca[m][2] + v0[2] * ca[m][3]) * sc;
                    const float o4 = (v1[0] * cb[m][0] - v1[1] * cb[m][1]) * sc, o5 = (v1[1] * cb[m][0] + v1[0] * cb[m][1]) * sc;
                    const float o6 = (v1[2] * cb[m][2] - v1[3] * cb[m][3]) * sc, o7 = (v1[3] * cb[m][2] + v1[2] * cb[m][3]) * sc;
                    u32x4 w; w.x = cvtpk(o0, o1); w.y = cvtpk(o2, o3); w.z = cvtpk(o4, o5); w.w = cvtpk(o6, o7);
                    *(u32x4*)(rowp + bj * 128) = w;
                }
            }
            asm volatile("" ::: "memory");
        }
    }
};

struct EpiWOut {
    static constexpr bool PERM = true;
    bf16* V; const float* xl; const float* xc; const bf16* xb; const float* mods;
    __device__ __forceinline__ void operator()(const f32x4 (&acc)[2][2][4][2], const pg8::Unit& u, int wr, int wc, int fr_, int fq_) const {
        int fr = fr_, fq = fq_; asm volatile("" : "+v"(fr), "+v"(fq));
        const int row0 = u.pm * 256 + wr * 64 + fr, col0 = u.pn * 256 + wc * 32 + 8 * fq;
        const int mr = u.pm < ML / 256 ? (u.pm >> 3) : 16;
        const float* g1 = mods + (size_t)mr * MODN + 2 * DM + col0;
        f32x4 gv[2][2];
#pragma unroll
        for (int bj = 0; bj < 2; ++bj)
#pragma unroll
            for (int n = 0; n < 2; ++n) gv[bj][n] = *(const f32x4*)(g1 + bj * 128 + n * 4);
#pragma unroll
        for (int ai = 0; ai < 2; ++ai) {
            f32x4 xr0[4][2], xr1[4][2];
#pragma unroll
            for (int m = 0; m < 4; ++m) { const int row = row0 + ai * 128 + m * 16;
#pragma unroll
                for (int bj = 0; bj < 2; ++bj) {
                    if (xl) { const float* xr = (row < ML ? xl + (size_t)row * DM : xc + (size_t)(row - ML) * DM) + col0 + bj * 128; xr0[m][bj] = *(const f32x4*)xr; xr1[m][bj] = *(const f32x4*)(xr + 4); }
                    else { const u32x4 xw = *(const u32x4*)(xb + (size_t)row * DM + col0 + bj * 128); xr0[m][bj] = (f32x4){bflo(xw.x), bfhi(xw.x), bflo(xw.y), bfhi(xw.y)}; xr1[m][bj] = (f32x4){bflo(xw.z), bfhi(xw.z), bflo(xw.w), bfhi(xw.w)}; } } }
#pragma unroll
            for (int m = 0; m < 4; ++m) { const int row = row0 + ai * 128 + m * 16; bf16* vr = V + (size_t)row * DM + col0;
#pragma unroll
                for (int bj = 0; bj < 2; ++bj) {
                    const f32x4 v0 = xr0[m][bj] * ALPHA + gv[bj][0] * acc[ai][bj][m][0], v1 = xr1[m][bj] * ALPHA + gv[bj][1] * acc[ai][bj][m][1];
                    u32x4 o; o.x = cvtpk(v0[0], v0[1]); o.y = cvtpk(v0[2], v0[3]); o.z = cvtpk(v1[0], v1[1]); o.w = cvtpk(v1[2], v1[3]);
                    *(u32x4*)(vr + bj * 128) = o; } }
            asm volatile("" ::: "memory");
        }
    }
};

struct EpiF32 {
    static constexpr bool PERM = false;
    float* C; int ldc;
    __device__ __forceinline__ void operator()(const f32x4 (&acc)[2][2][4][2], const pg8::Unit& u, int wr, int wc, int fr_, int fq_) const {
        int fr = fr_, fq = fq_; asm volatile("" : "+v"(fr), "+v"(fq));
        const int row0 = u.pm * 256 + wr * 64 + fr, col0 = u.pn * 256 + wc * 32 + 4 * fq;
#pragma unroll
        for (int ai = 0; ai < 2; ++ai)
#pragma unroll
            for (int m = 0; m < 4; ++m) { float* rowp = C + (size_t)(row0 + ai * 128 + m * 16) * ldc + col0;
#pragma unroll
                for (int bj = 0; bj < 2; ++bj)
#pragma unroll
                    for (int n = 0; n < 2; ++n) *(f32x4*)(rowp + bj * 128 + n * 16) = acc[ai][bj][m][n]; }
    }
};

struct MoeTables { const LAS int* toff; const LAS int* cnt; };
__device__ __forceinline__ bool moe_unit(const MoeTables& Tb, long L, int nct, pg8::Unit& u) {
    const int ntile = Tb.toff[32];
    if (L >= (long)ntile * nct) return false;
    const int rt = (int)(L / nct); u.pm = rt; u.pn = (int)(L % nct);
    int e = 0;
#pragma unroll
    for (int j = 1; j < 32; ++j) e += (rt >= Tb.toff[j]) ? 1 : 0;
    u.e = e; u.lrow0 = (rt - Tb.toff[e]) * 256; const int rem = Tb.cnt[e] - u.lrow0; u.valid = rem < 256 ? rem : 256;
    return true;
}
struct ProbGU {
    int K; const bf16* A; const bf16* Bt; const unsigned* list; MoeTables Tb; int G, c;
    __device__ __forceinline__ bool next(int i, pg8::Unit& u) const { return moe_unit(Tb, (long)i * G + c, 4, u); }
    static constexpr bool GATHER = true;
    __device__ __forceinline__ const char* a_base(const pg8::Unit&) const { return (const char*)A; }
    __device__ __forceinline__ void a_setup(const pg8::Unit& u, const char*& base, unsigned (&va)[2][2], int tid) const {
        base = (const char*)A; const unsigned* lp = list + (size_t)u.e * LISTCAP + u.lrow0;
#pragma unroll
        for (int i = 0; i < 2; ++i) { int R, C; pg8::stage_rc(tid * 16 + i * 8192, R, C);
#pragma unroll
            for (int h = 0; h < 2; ++h) { const int r = h * 128 + R; const unsigned raw = lp[r];
                const unsigned ent = (r < u.valid) ? raw : 0u; va[h][i] = ((ent >> 1) * (unsigned)K + (unsigned)C) * 2u; } }
    }
    __device__ __forceinline__ const char* b_base(const pg8::Unit& u) const { return (const char*)(Bt + ((size_t)u.e * 1024 + (size_t)u.pn * 256) * K); }
};
struct EpiGU {
    static constexpr bool PERM = true;
    bf16* HID;
    __device__ __forceinline__ void operator()(const f32x4 (&acc)[2][2][4][2], const pg8::Unit& u, int wr, int wc, int fr_, int fq_) const {
        int fr = fr_, fq = fq_; asm volatile("" : "+v"(fr), "+v"(fq));
        const int row0 = u.pm * 256 + wr * 64 + fr, col0 = u.pn * 128 + wc * 32 + fq * 8;
#pragma unroll
        for (int ai = 0; ai < 2; ++ai)
#pragma unroll
            for (int m = 0; m < 4; ++m) {
                const f32x4 g0 = acc[ai][0][m][0], g1 = acc[ai][0][m][1], u0 = acc[ai][1][m][0], u1 = acc[ai][1][m][1];
                u32x4 w; w.x = cvtpk(silu_f(g0[0]) * u0[0], silu_f(g0[1]) * u0[1]); w.y = cvtpk(silu_f(g0[2]) * u0[2], silu_f(g0[3]) * u0[3]);
                w.z = cvtpk(silu_f(g1[0]) * u1[0], silu_f(g1[1]) * u1[1]); w.w = cvtpk(silu_f(g1[2]) * u1[2], silu_f(g1[3]) * u1[3]);
                *(u32x4*)(HID + (size_t)(row0 + ai * 128 + m * 16) * MOEH + col0) = w;
            }
    }
};
struct ProbDown {
    int K; const bf16* A; const bf16* Bt; MoeTables Tb; int G, c;
    __device__ __forceinline__ bool next(int i, pg8::Unit& u) const { return moe_unit(Tb, (long)i * G + c, 8, u); }
    static constexpr bool GATHER = false;
    __device__ __forceinline__ const char* a_base(const pg8::Unit& u) const { return (const char*)(A + (size_t)u.pm * 256 * K); }
    __device__ __forceinline__ void a_setup(const pg8::Unit& u, const char*& base, unsigned (&va)[2][2], int tid) const { base = a_base(u); pg8::dense_offsets(K, va, tid); }
    __device__ __forceinline__ const char* b_base(const pg8::Unit& u) const { return (const char*)(Bt + ((size_t)u.e * DM + (size_t)u.pn * 256) * K); }
};
struct EpiDown {
    static constexpr bool PERM = true;
    bf16* Y2; const unsigned* list; const float* wlist;
    __device__ __forceinline__ void operator()(const f32x4 (&acc)[2][2][4][2], const pg8::Unit& u, int wr, int wc, int fr_, int fq_) const {
        int fr = fr_, fq = fq_; asm volatile("" : "+v"(fr), "+v"(fq));
        const int col0 = u.pn * 256 + wc * 32 + fq * 8;
        const size_t lb = (size_t)u.e * LISTCAP + u.lrow0;
        unsigned ent[8]; float wt[8];
#pragma unroll
        for (int i = 0; i < 8; ++i) { const int lr = (i >> 2) * 128 + wr * 64 + (i & 3) * 16 + fr; const bool ok = lr < u.valid; const unsigned er = list[lb + lr]; const float wr_ = wlist[lb + lr];
            ent[i] = ok ? er : 0xffffffffu; wt[i] = ok ? wr_ : 0.f; }
#pragma unroll
        for (int ai = 0; ai < 2; ++ai)
#pragma unroll
            for (int m = 0; m < 4; ++m) {
                const unsigned en = ent[ai * 4 + m]; const float w = wt[ai * 4 + m];
                if (en != 0xffffffffu) {
                    bf16* rowp = Y2 + ((size_t)(en & 1u) * MA + (en >> 1)) * DM + col0;
#pragma unroll
                    for (int bj = 0; bj < 2; ++bj) { const f32x4 v0 = acc[ai][bj][m][0] * w, v1 = acc[ai][bj][m][1] * w;
                        u32x4 o; o.x = cvtpk(v0[0], v0[1]); o.y = cvtpk(v0[2], v0[3]); o.z = cvtpk(v1[0], v1[1]); o.w = cvtpk(v1[2], v1[3]);
                        *(u32x4*)(rowp + bj * 128) = o; }
                }
            }
    }
};

struct ProbProj {
    int K; const bf16* A; const bf16* Bt; pg8::StaticOrder S; int G, c;
    __device__ __forceinline__ bool next(int i, pg8::Unit& u) const {
        u.e = 0; u.lrow0 = 0; u.valid = 256;
        if (S.map(i, u.pm, u.pn)) return true;
        const long L = (long)i * G + c - S.nwg; if (L < 0 || L >= 16 * 12) return false;
        u.pm = ML / 256 + (int)(L / 12); u.pn = 4 + (int)(L % 12); return true;
    }
    static constexpr bool GATHER = false;
    __device__ __forceinline__ const char* a_base(const pg8::Unit& u) const { return (const char*)(A + (size_t)u.pm * 256 * K); }
    __device__ __forceinline__ void a_setup(const pg8::Unit& u, const char*& base, unsigned (&va)[2][2], int tid) const { base = a_base(u); pg8::dense_offsets(K, va, tid); }
    __device__ __forceinline__ const char* b_base(const pg8::Unit& u) const { return (const char*)(Bt + (size_t)u.pn * 256 * K); }
};
struct EpiProj {
    static constexpr bool PERM = true;
    bf16* GQ; bf16* GK; bf16* GV; bf16* GR; float* GU;
    __device__ __forceinline__ void operator()(const f32x4 (&acc)[2][2][4][2], const pg8::Unit& u, int wr, int wc, int fr_, int fq_) const {
        int fr = fr_, fq = fq_; asm volatile("" : "+v"(fr), "+v"(fq));
        const int row0 = u.pm * 256 + wr * 64 + fr, cw = wc * 32 + fq * 8;
        if (u.pn == 24) {
            if (wc == 0) {
#pragma unroll
                for (int ai = 0; ai < 2; ++ai)
#pragma unroll
                    for (int m = 0; m < 4; ++m) { float* rp = GU + (size_t)(row0 + ai * 128 + m * 16) * 32 + fq * 8;
                        *(f32x4*)rp = acc[ai][0][m][0]; *(f32x4*)(rp + 4) = acc[ai][0][m][1]; }
            }
            return;
        }
        bf16* dst; int ldc, colt; bool act = false;
        if (u.pn < 4) { dst = GQ; ldc = 1024; colt = u.pn * 256; }
        else if (u.pn < 8) { dst = GK; ldc = 1024; colt = (u.pn - 4) * 256; }
        else if (u.pn < 16) { dst = GV; ldc = 2048; colt = (u.pn - 8) * 256; }
        else { dst = GR; ldc = 2048; colt = (u.pn - 16) * 256; act = true; }
#pragma unroll
        for (int ai = 0; ai < 2; ++ai)
#pragma unroll
            for (int m = 0; m < 4; ++m) { bf16* rowp = dst + (size_t)(row0 + ai * 128 + m * 16) * ldc + colt + cw;
#pragma unroll
                for (int bj = 0; bj < 2; ++bj) { f32x4 v0 = acc[ai][bj][m][0], v1 = acc[ai][bj][m][1];
                    if (act) {
#pragma unroll
                        for (int j = 0; j < 4; ++j) { v0[j] = silu_f(v0[j]); v1[j] = silu_f(v1[j]); } }
                    u32x4 o; o.x = cvtpk(v0[0], v0[1]); o.y = cvtpk(v0[2], v0[3]); o.z = cvtpk(v1[0], v1[1]); o.w = cvtpk(v1[2], v1[3]);
                    *(u32x4*)(rowp + bj * 128) = o; }
                asm volatile("" ::: "memory"); }
    }
};
__device__ __forceinline__ void ph_mods(Frame& F) {
    LAS float* S = (LAS float*)F.lds;
    const float* c = F.in[I_C]; const float* cc = F.in[I_CCTX]; const float* mw = F.in[I_MODW]; const float* mb = F.in[I_MODB];
    float* mods = (float*)(F.ws + WS_MODS);
    for (int item = blockIdx.x; item < 2 * 96; item += F.G) {
        const int l = item / 96, n0 = (item % 96) * 128;
        __syncthreads();
        for (int idx = F.tid; idx < 17 * DM; idx += NTHREADS) { const int r = idx >> 11, k = idx & (DM - 1); const float v = r < 16 ? c[r * DM + k] : cc[k]; S[idx] = v / (1.f + __expf(-v)); }
        __syncthreads();
        const int g = F.tid & 31, ks = F.tid >> 5;
        f32x4 acc[17];
#pragma unroll
        for (int r = 0; r < 17; ++r) acc[r] = (f32x4){0.f, 0.f, 0.f, 0.f};
        const float* w = mw + (size_t)l * DM * MODN + n0 + 4 * g;
#pragma unroll 4
        for (int i = 0; i < 32; ++i) { const int k = ks * 128 + 4 * i; f32x4 wv[4];
#pragma unroll
            for (int q = 0; q < 4; ++q) wv[q] = *(const f32x4*)(w + (size_t)(k + q) * MODN);
#pragma unroll
            for (int r = 0; r < 17; ++r) { const f32x4 sv = *(const LAS f32x4*)(S + r * DM + k); acc[r] += wv[0] * sv[0]; acc[r] += wv[1] * sv[1]; acc[r] += wv[2] * sv[2]; acc[r] += wv[3] * sv[3]; } }
#pragma unroll
        for (int r = 0; r < 17; ++r)
#pragma unroll
            for (int j = 0; j < 4; ++j) acc[r][j] += __shfl_xor(acc[r][j], 32);
        __syncthreads();
        LAS f32x4* red = (LAS f32x4*)F.lds;
        if (F.lane < 32) {
#pragma unroll
            for (int r = 0; r < 17; ++r) red[(F.wave * 17 + r) * 32 + g] = acc[r];
        }
        __syncthreads();
        for (int o = F.tid; o < 17 * 32; o += NTHREADS) { const int r = o >> 5, gg = o & 31; f32x4 s = *(const f32x4*)(mb + (size_t)l * MODN + n0 + 4 * gg);
#pragma unroll
            for (int wv = 0; wv < 8; ++wv) s += red[(wv * 17 + r) * 32 + gg];
            *(f32x4*)(mods + ((size_t)(l * 17 + r) * MODN + n0 + 4 * gg)) = s; }
    }
    __syncthreads();
}

template <class RowMap>
__device__ __forceinline__ void conv_item(const float* W, int ldw, int K, bf16* WT, const RowMap& rm, float scale, LAS float* scr, int nblk, int item, int lane) {
    const int kb = item / nblk, nb = item % nblk, k0 = 64 * kb, n0 = 64 * nb, lr = lane >> 4, lg = lane & 15;
    f32x4 v[16];
#pragma unroll
    for (int i = 0; i < 16; ++i) v[i] = *(const f32x4*)(W + (size_t)(k0 + 4 * i + lr) * ldw + n0 + 4 * lg);
#pragma unroll
    for (int i = 0; i < 16; ++i) { LAS float* d = scr + (4 * i + lr) * 65 + 4 * lg; d[0] = v[i][0]; d[1] = v[i][1]; d[2] = v[i][2]; d[3] = v[i][3]; }
    LDS_WAIT(); asm volatile("" ::: "memory");
    const int c = lane & 7;
#pragma unroll
    for (int j = 0; j < 8; ++j) { const int n = (lane >> 3) + 8 * j; const LAS float* s = scr + (8 * c) * 65 + n;
        u32x4 o; o.x = cvtpk(s[0 * 65] * scale, s[1 * 65] * scale); o.y = cvtpk(s[2 * 65] * scale, s[3 * 65] * scale); o.z = cvtpk(s[4 * 65] * scale, s[5 * 65] * scale); o.w = cvtpk(s[6 * 65] * scale, s[7 * 65] * scale);
        *(u32x4*)(WT + (size_t)rm(n0 + n) * K + k0 + 8 * c) = o; }
    LDS_WAIT(); asm volatile("" ::: "memory");
}
struct RmId { __device__ __forceinline__ int operator()(int n) const { return n; } };
struct RmQKV {
    __device__ __forceinline__ int operator()(int n) const { if (n >= 2560) return n; const int dd = n & 127, base = n - dd, hh = dd >> 6, d2 = dd & 63; return base + hh * 64 + 2 * (d2 & 31) + (d2 >> 5); } };
struct RmGU { int up; __device__ __forceinline__ int operator()(int n) const { return 256 * (n >> 7) + 128 * up + (n & 127); } };

constexpr int CV_IG = (DM / 64) * (MOEH / 64), CV_ID = (MOEH / 64) * (DM / 64), CV_MOE_ITEMS = NEXP * (2 * CV_IG + CV_ID);
__device__ __forceinline__ void conv_moe_item(Frame& F, int l, int it, LAS float* scr) {
    bf16* WGU = (bf16*)(F.ws + WS_WGU); bf16* WD = (bf16*)(F.ws + WS_WD);
    const float* wg = F.in[I_MWG] + (size_t)l * NEXP * DM * MOEH; const float* wu = F.in[I_MWU] + (size_t)l * NEXP * DM * MOEH; const float* wd = F.in[I_MWD] + (size_t)l * NEXP * MOEH * DM;
    const int e = it / (2 * CV_IG + CV_ID); int r = it % (2 * CV_IG + CV_ID);
    if (r < CV_IG) { conv_item(wg + (size_t)e * DM * MOEH, MOEH, DM, WGU + (size_t)e * 1024 * DM, RmGU{0}, 1.f, scr, MOEH / 64, r, F.lane); return; } r -= CV_IG;
    if (r < CV_IG) { conv_item(wu + (size_t)e * DM * MOEH, MOEH, DM, WGU + (size_t)e * 1024 * DM, RmGU{1}, 1.f, scr, MOEH / 64, r, F.lane); return; } r -= CV_IG;
    conv_item(wd + (size_t)e * MOEH * DM, DM, MOEH, WD + (size_t)e * DM * MOEH, RmId{}, 1.f, scr, DM / 64, r, F.lane);
}
__device__ __forceinline__ void ph_conv_moe(Frame& F, int l) {
    LAS float* scr = (LAS float*)(F.lds + F.wave * 16640);
    const int gw = F.vcu * NWAVES + F.wave, NGW = F.G * NWAVES;
    for (int it = gw; it < CV_MOE_ITEMS; it += NGW) conv_moe_item(F, l, it, scr);
}
__device__ __forceinline__ void ph_conv0(Frame& F) {
    LAS float* scr = (LAS float*)(F.lds + F.wave * 16640);
    bf16* WQKV = (bf16*)(F.ws + WS_WQKV); bf16* WO = (bf16*)(F.ws + WS_WO); bf16* WIN = (bf16*)(F.ws + WS_WIN); bf16* WO2 = (bf16*)(F.ws + WS_WO2); bf16* WR = (bf16*)(F.ws + WS_WR);
    constexpr int I_Q = (DM / 64) * (NQKV / 64), I_O = (DM / 64) * (DM / 64), I_N = (DM / 64) * (6144 / 64), I_SMALL = I_Q + 2 * I_O + I_N, I_ALL = I_SMALL + CV_MOE_ITEMS;
    for (;;) {
        int base = 0; if (F.lane == 0) base = (int)atomicAdd(F.ctl + CW_WQ, 8u);
        base = __builtin_amdgcn_readfirstlane(base);
        if (base >= I_ALL) break;
        for (int it = base; it < base + 8 && it < I_ALL; ++it) {
            int r = it;
            if (r >= I_SMALL) { conv_moe_item(F, 0, r - I_SMALL, scr); continue; }
            if (r < I_Q) { conv_item(F.in[I_WQKV], NQKV, DM, WQKV, RmQKV{}, 1.f, scr, NQKV / 64, r, F.lane); continue; } r -= I_Q;
            if (r < I_O) { conv_item(F.in[I_WOA], DM, DM, WO, RmId{}, 1.f, scr, DM / 64, r, F.lane); continue; } r -= I_O;
            if (r < I_O) { conv_item(F.in[I_WOG], DM, DM, WO2, RmId{}, 1.f, scr, DM / 64, r, F.lane); continue; } r -= I_O;
            const int nb = r % (6144 / 64);
            conv_item(F.in[I_WIN], 6144, DM, WIN, RmId{}, nb < 16 ? 0.0625f : 1.f, scr, 6144 / 64, r, F.lane);
        }
    }
    const size_t gt = (size_t)(blockIdx.x) * NTHREADS + F.tid, gn = (size_t)F.G * NTHREADS;
    for (size_t i = gt; i < (size_t)224 * DM; i += gn) WIN[(size_t)(6176) * DM + i] = 0;
    for (size_t i = gt; i < (size_t)2 * DM * 16; i += gn) { const int d = (int)(i / (DM * 16)), k = (int)((i / 16) % DM), r = (int)(i % 16); WIN[(size_t)(6144 + 16 * d + r) * DM + k] = f2bf(F.in[I_GW1][i]); }
    for (size_t i = gt; i < (size_t)2 * 36 * DM; i += gn) { const int l = (int)(i / (36 * DM)), j = (int)((i / DM) % 36), k = (int)(i % DM);
        const float w = j < 4 ? F.in[I_MGW][((size_t)l * DM + k) * 4 + j] : F.in[I_MRW][((size_t)l * DM + k) * 32 + (j - 4)];
        const unsigned short hi = f2bf(w); const float lo = w - bf2f(hi);
        WR[((size_t)l * 256 + j) * DM + k] = hi; WR[((size_t)l * 256 + 36 + j) * DM + k] = f2bf(lo); }
    for (size_t i = gt; i < (size_t)2 * 184 * DM; i += gn) { const int l = (int)(i / (184 * DM)); const size_t o = i % ((size_t)184 * DM); WR[((size_t)l * 256 + 72) * DM + o] = 0; }
    float* cs = (float*)(F.ws + WS_ROPE);
    for (size_t i = gt; i < 64 * 32; i += gn) { const int pos = (int)(i >> 5), fi = (int)(i & 31); const float inv = powf(10000.f, -(float)(2 * fi) / 64.f); const float ang = (float)pos * inv;
        cs[2 * i] = cosf(ang); cs[2 * i + 1] = sinf(ang); }
}

__device__ __forceinline__ void row_load_f32(const float* p, int lane, float (&v)[32]) {
#pragma unroll
    for (int j = 0; j < 4; ++j) { const f32x4 a = *(const f32x4*)(p + 8 * lane + 512 * j), b = *(const f32x4*)(p + 8 * lane + 512 * j + 4);
        v[8 * j] = a[0]; v[8 * j + 1] = a[1]; v[8 * j + 2] = a[2]; v[8 * j + 3] = a[3]; v[8 * j + 4] = b[0]; v[8 * j + 5] = b[1]; v[8 * j + 6] = b[2]; v[8 * j + 7] = b[3]; }
}
__device__ __forceinline__ void row_load_bf16(const bf16* p, int lane, float (&v)[32]) {
#pragma unroll
    for (int j = 0; j < 4; ++j) { const u32x4 a = *(const u32x4*)(p + 8 * lane + 512 * j);
#pragma unroll
        for (int q = 0; q < 4; ++q) { v[8 * j + 2 * q] = bflo(a[q]); v[8 * j + 2 * q + 1] = bfhi(a[q]); } }
}
__device__ __forceinline__ void row_store_bf16(bf16* p, int lane, const float (&v)[32]) {
#pragma unroll
    for (int j = 0; j < 4; ++j) { u32x4 o; o.x = cvtpk(v[8 * j], v[8 * j + 1]); o.y = cvtpk(v[8 * j + 2], v[8 * j + 3]); o.z = cvtpk(v[8 * j + 4], v[8 * j + 5]); o.w = cvtpk(v[8 * j + 6], v[8 * j + 7]);
        *(u32x4*)(p + 8 * lane + 512 * j) = o; }
}
__device__ __forceinline__ void row_store_f32(float* p, int lane, const float (&v)[32]) {
#pragma unroll
    for (int j = 0; j < 4; ++j) { *(f32x4*)(p + 8 * lane + 512 * j) = (f32x4){v[8 * j], v[8 * j + 1], v[8 * j + 2], v[8 * j + 3]}; *(f32x4*)(p + 8 * lane + 512 * j + 4) = (f32x4){v[8 * j + 4], v[8 * j + 5], v[8 * j + 6], v[8 * j + 7]}; }
}
__device__ __forceinline__ void row_ln(float (&v)[32], const float* g, const float* b, int lane) {
    float s = 0.f;
#pragma unroll
    for (int i = 0; i < 32; ++i) s += v[i];
    const float mean = wave_sum(s) * (1.f / DM); float q = 0.f;
#pragma unroll
    for (int i = 0; i < 32; ++i) { v[i] -= mean; q += v[i] * v[i]; }
    const float rstd = 1.f / sqrtf(wave_sum(q) * (1.f / DM) + LN_EPS);
    float gv[32], bv[32]; row_load_f32(g, lane, gv); row_load_f32(b, lane, bv);
#pragma unroll
    for (int i = 0; i < 32; ++i) v[i] = v[i] * rstd * gv[i] + bv[i];
}
__device__ __forceinline__ void row_mod(float (&v)[32], const float* sh, const float* sc, int lane) {
    float a[32], b[32]; row_load_f32(sc, lane, a); row_load_f32(sh, lane, b);
#pragma unroll
    for (int i = 0; i < 32; ++i) v[i] = v[i] * (a[i] + 1.f) + b[i];
}
__device__ __forceinline__ void ph_mod0(Frame& F) {
    const int gw = F.vcu * NWAVES + F.wave, NGW = F.G * NWAVES; bf16* HB = (bf16*)(F.ws + WS_HB);
    for (int m = gw; m < MA; m += NGW) {
        const float* xr = m < ML ? F.in[I_X] + (size_t)m * DM : F.in[I_CTX] + (size_t)(m - ML) * DM; const int mr = mod_row(m);
        float v[32]; row_load_f32(xr, F.lane, v); row_mod(v, mods_ptr(F, 0, mr, 0), mods_ptr(F, 0, mr, 1), F.lane); row_store_bf16(HB + (size_t)m * DM, F.lane, v);
    }
}
__device__ __forceinline__ void ph_ln1(Frame& F, int l) {
    const int gw = F.vcu * NWAVES + F.wave, NGW = F.G * NWAVES; bf16* HB = (bf16*)(F.ws + WS_HB); bf16* VX = (bf16*)(F.ws + WS_VX);
    const int M = l ? ML : MA; const float* g = F.in[I_LNG] + (size_t)(l * 2 + 0) * DM; const float* b = F.in[I_LNB] + (size_t)(l * 2 + 0) * DM;
    for (int m = gw; m < M; m += NGW) { const int mr = mod_row(m);
        float v[32]; row_load_bf16(VX + (size_t)m * DM, F.lane, v); row_ln(v, g, b, F.lane);
        row_store_bf16(VX + (size_t)m * DM, F.lane, v);
        row_mod(v, mods_ptr(F, l, mr, 3), mods_ptr(F, l, mr, 4), F.lane); row_store_bf16(HB + (size_t)m * DM, F.lane, v); }
}
__device__ __forceinline__ void ph_ln2(Frame& F, int l) {
    const int gw = F.vcu * NWAVES + F.wave, NGW = F.G * NWAVES; bf16* HB = (bf16*)(F.ws + WS_HB); const bf16* VX = (const bf16*)(F.ws + WS_VX); const bf16* Y2 = (const bf16*)(F.ws + WS_Y2);
    const int M = l ? ML : MA; const float* g = F.in[I_LNG] + (size_t)(l * 2 + 1) * DM; const float* b = F.in[I_LNB] + (size_t)(l * 2 + 1) * DM;
    for (int m = gw; m < M; m += NGW) { const int mr = mod_row(m);
        float v[32], ya[32], yb[32], g2[32]; row_load_bf16(VX + (size_t)m * DM, F.lane, v); row_load_bf16(Y2 + (size_t)m * DM, F.lane, ya); row_load_bf16(Y2 + ((size_t)MA + m) * DM, F.lane, yb); row_load_f32(mods_ptr(F, l, mr, 5), F.lane, g2);
#pragma unroll
        for (int i = 0; i < 32; ++i) v[i] = v[i] * ALPHA + g2[i] * (ya[i] + yb[i]);
        row_ln(v, g, b, F.lane);
        if (l == 1) row_store_f32(F.out + (size_t)m * DM, F.lane, v);
        else { if (m < ML) row_store_bf16((bf16*)F.out + (size_t)m * DM, F.lane, v);
            row_mod(v, mods_ptr(F, 1, mr, 0), mods_ptr(F, 1, mr, 1), F.lane); row_store_bf16(HB + (size_t)m * DM, F.lane, v); } }
}


constexpr int SK_RS = 272, SK_A = 32 * SK_RS;
template <int NB>
__device__ __forceinline__ void skinny_gemm(Frame& F, const bf16* A, const bf16* W, float* out, int ldo, int M) {
    const int lane = F.lane, r32 = lane & 31, hi = lane >> 5, tid = F.tid, w = F.wave;
    LAS unsigned char* Al = F.lds + w * SK_A; LAS unsigned char* Wl = F.lds + NWAVES * SK_A;
    const int nblk = M / 32, npass = (nblk + NWAVES * F.G - 1) / (NWAVES * F.G);
    for (int pass = 0; pass < npass; ++pass) {
        const int blk = pass * NWAVES * F.G + w * F.G + F.vcu; const bool have = blk < nblk;
        f32x16 acc[NB];
#pragma unroll
        for (int nb = 0; nb < NB; ++nb)
#pragma unroll
            for (int r = 0; r < 16; ++r) acc[nb][r] = 0.f;
        const char* ag = (const char*)A + ((size_t)blk * 32 + (lane >> 4)) * (DM * 2) + (lane & 15) * 16;
        const int al = (lane >> 4) * SK_RS + (lane & 15) * 16;
        u32x4 ra[8], rw[NB];
#define SK_LOAD(sl_) do { if (have) { _Pragma("unroll") for (int i_ = 0; i_ < 8; ++i_) ra[i_] = *(const u32x4*)(ag + (size_t)i_ * 4 * (DM * 2) + (sl_) * 256); } \
            _Pragma("unroll") for (int i_ = 0; i_ < NB; ++i_) { const int idx_ = tid + 512 * i_; rw[i_] = *(const u32x4*)((const char*)W + (size_t)(idx_ >> 4) * (DM * 2) + (sl_) * 256 + (idx_ & 15) * 16); } } while (0)
        SK_LOAD(0);
#pragma unroll 1
        for (int sl = 0; sl < DM / 128; ++sl) {
            __syncthreads();
            if (have) {
#pragma unroll
                for (int i = 0; i < 8; ++i) *(LAS u32x4*)(Al + al + i * 4 * SK_RS) = ra[i]; }
#pragma unroll
            for (int i = 0; i < NB; ++i) { const int idx = tid + 512 * i; *(LAS u32x4*)(Wl + (idx >> 4) * SK_RS + (idx & 15) * 16) = rw[i]; }
            __syncthreads();
            if (sl + 1 < DM / 128) SK_LOAD(sl + 1);
            if (have) {
#pragma unroll
                for (int ks = 0; ks < 8; ++ks) {
                    const bf16x8 a = *(const LAS bf16x8*)(Al + r32 * SK_RS + (16 * ks + 8 * hi) * 2);
#pragma unroll
                    for (int nb = 0; nb < NB; ++nb) { const bf16x8 b = *(const LAS bf16x8*)(Wl + (32 * nb + r32) * SK_RS + (16 * ks + 8 * hi) * 2); acc[nb] = MFMA32(a, b, acc[nb]); }
                } }
        }
#undef SK_LOAD
        if (have) {
#pragma unroll
            for (int nb = 0; nb < NB; ++nb)
#pragma unroll
                for (int r = 0; r < 16; ++r) out[(size_t)(blk * 32 + crow(r, hi)) * ldo + 32 * nb + r32] = acc[nb][r]; }
    }
    __syncthreads();
}

__device__ __forceinline__ void ph_topk(Frame& F, int l) {
    const int M = l ? ML : MA; const float* LOG = (const float*)(F.ws + WS_LOG); unsigned* list = (unsigned*)(F.ws + WS_LIST); float* wlist = (float*)(F.ws + WS_WLIST);
    const float* gb = F.in[I_MGB] + l * 4; const float* rb = F.in[I_MRB] + l * 32; unsigned* cnt = F.ctl + CW_CNT + l * 32 * CW_STRIDE;
    const int nblk = M / 32, nslot = ((nblk + NWAVES * F.G - 1) / (NWAVES * F.G)) * NWAVES;
    for (int i = F.tid >> 5; i < nslot; i += NTHREADS / 32) {
        const int blk = (i >> 3) * NWAVES * F.G + (i & 7) * F.G + F.vcu; if (blk >= nblk) continue;
        const int m = blk * 32 + (F.tid & 31);
        const float* lg = LOG + (size_t)m * 256; float v[72];
#pragma unroll
        for (int j = 0; j < 18; ++j) { const f32x4 t = __builtin_nontemporal_load((const f32x4*)(lg + 4 * j)); v[4 * j] = t[0]; v[4 * j + 1] = t[1]; v[4 * j + 2] = t[2]; v[4 * j + 3] = t[3]; }
        float gl[4]; int gi = 0;
#pragma unroll
        for (int j = 0; j < 4; ++j) gl[j] = v[j] + v[36 + j] + gb[j];
        float gm = gl[0];
#pragma unroll
        for (int j = 1; j < 4; ++j) if (gl[j] > gm) { gm = gl[j]; gi = j; }
        float den = 0.f;
#pragma unroll
        for (int j = 0; j < 4; ++j) den += __expf(gl[j] - gm);
        const float gw = 1.f / den;
        float el[8];
#pragma unroll
        for (int j = 0; j < 8; ++j) { float a = 0.f;
#pragma unroll
            for (int q = 0; q < 4; ++q) { const float x = v[4 + q * 8 + j] + v[40 + q * 8 + j]; a = (q == gi) ? x : a; }
            el[j] = a + rb[gi * 8 + j]; }
        int i0 = 0; float v0 = el[0];
#pragma unroll
        for (int j = 1; j < 8; ++j) if (el[j] > v0) { v0 = el[j]; i0 = j; }
        int i1 = -1; float v1 = -3.0e38f;
#pragma unroll
        for (int j = 0; j < 8; ++j) if (j != i0 && el[j] > v1) { v1 = el[j]; i1 = j; }
        const float e1 = __expf(v1 - v0), w0 = gw / (1.f + e1), w1 = gw * e1 / (1.f + e1);
        const int ea = gi * 8 + i0, eb = gi * 8 + i1;
        const unsigned pa = atomicAdd(cnt + ea * CW_STRIDE, 1u), pb = atomicAdd(cnt + eb * CW_STRIDE, 1u);
        list[(size_t)ea * LISTCAP + pa] = 2u * m; wlist[(size_t)ea * LISTCAP + pa] = w0;
        list[(size_t)eb * LISTCAP + pb] = 2u * m + 1u; wlist[(size_t)eb * LISTCAP + pb] = w1;
    }
}
__device__ __forceinline__ MoeTables moe_tables(Frame& F, int l) {
    LAS int* toff = (LAS int*)(F.lds + MISC_OFF + 256); LAS int* cn = (LAS int*)(F.lds + MISC_OFF + 512);
    __syncthreads();
    if (F.tid < 32) {
        const int e = F.tid; const int n = (int)__hip_atomic_load(F.ctl + CW_CNT + (l * 32 + e) * CW_STRIDE, RLX_AGENT); const int tl = (n + 255) >> 8;
        int inc = tl;
#pragma unroll
        for (int d = 1; d < 32; d <<= 1) { const int t = __shfl_up(inc, d, 32); if (e >= d) inc += t; }
        cn[e] = n; toff[e] = inc - tl; if (e == 31) toff[32] = inc; }
    __syncthreads();
    MoeTables T; T.toff = toff; T.cnt = cn; return T;
}

__device__ __forceinline__ void ph_gates(Frame& F) {
    const float* GU = (const float*)(F.ws + WS_GU); float* BF = (float*)(F.ws + WS_VX); float* BB = BF + (size_t)MA * 1024;
    const float* gw2 = F.in[I_GW2]; const float* gbp = F.in[I_GB];
    LAS float* us = (LAS float*)F.lds;
    for (int ch = blockIdx.x; ch < MA / 32; ch += F.G) {
        __syncthreads();
        for (int i = F.tid; i < 1024; i += NTHREADS) us[i] = GU[(size_t)ch * 1024 + i];
        __syncthreads();
#pragma unroll 1
        for (int j = 0; j < 2; ++j) { const int c = F.tid + 512 * j;
#pragma unroll 1
            for (int d = 0; d < 2; ++d) {
                float w[16]; const float bias = gbp[d * 1024 + c];
#pragma unroll
                for (int r = 0; r < 16; ++r) w[r] = gw2[((size_t)d * 16 + r) * 1024 + c];
                float lgv[32];
#pragma unroll
                for (int t = 0; t < 32; ++t) { float p = bias; const LAS f32x4* up = (const LAS f32x4*)(us + t * 32 + d * 16);
#pragma unroll
                    for (int r4 = 0; r4 < 4; ++r4) { const f32x4 u4 = up[r4]; p += u4[0] * w[4 * r4] + u4[1] * w[4 * r4 + 1] + u4[2] * w[4 * r4 + 2] + u4[3] * w[4 * r4 + 3]; }
                    lgv[t] = (fminf(p, 0.f) - __logf(1.f + __expf(-fabsf(p)))) * 0.0625f; }
                float* dst = (d == 0 ? BF : BB) + (size_t)ch * 32 * 1024 + c;
                if (d == 0) { float a = 0.f;
#pragma unroll
                    for (int t = 0; t < 32; ++t) { a += lgv[t]; dst[(size_t)t * 1024] = a; } }
                else { float a = 0.f;
#pragma unroll
                    for (int t = 31; t >= 0; --t) { a += lgv[t]; dst[(size_t)t * 1024] = a; } }
            } }
    }
    __syncthreads();
}

__device__ __forceinline__ void ph_readout(Frame& F) {
    const int gw = F.vcu * NWAVES + F.wave, NGW = F.G * NWAVES;
    const bf16* OF = (const bf16*)(F.ws + WS_HB); const bf16* OB = (const bf16*)(F.ws + WS_OB); const bf16* GR = (const bf16*)(F.ws + WS_GR); bf16* A2 = (bf16*)(F.ws + WS_A2); const float* ng = F.in[I_NG];
    for (int m = gw; m < ML; m += NGW) {
        const size_t off = (size_t)m * DM + F.lane * 32;
        float o[32]; float ss = 0.f;
#pragma unroll
        for (int j = 0; j < 4; ++j) { const u32x4 a = *(const u32x4*)(OF + off + 8 * j), b = *(const u32x4*)(OB + off + 8 * j);
#pragma unroll
            for (int q = 0; q < 4; ++q) { const float lo = bflo(a[q]) + bflo(b[q]), hi = bfhi(a[q]) + bfhi(b[q]); o[8 * j + 2 * q] = lo; o[8 * j + 2 * q + 1] = hi; ss += lo * lo + hi * hi; } }
        ss += __shfl_xor(ss, 1); ss += __shfl_xor(ss, 2); ss += __shfl_xor(ss, 4); ss += __shfl_xor(ss, 8);
        const float rs = 1.f / sqrtf(ss * (1.f / GDV) + RMS_EPS);
        const int hc = (F.lane & 15) * 32;
#pragma unroll
        for (int j = 0; j < 4; ++j) { const u32x4 r = *(const u32x4*)(GR + off + 8 * j); const f32x4 g0 = *(const f32x4*)(ng + hc + 8 * j), g1 = *(const f32x4*)(ng + hc + 8 * j + 4);
            u32x4 w; w.x = cvtpk(o[8 * j] * rs * g0[0] * bflo(r.x), o[8 * j + 1] * rs * g0[1] * bfhi(r.x)); w.y = cvtpk(o[8 * j + 2] * rs * g0[2] * bflo(r.y), o[8 * j + 3] * rs * g0[3] * bfhi(r.y));
            w.z = cvtpk(o[8 * j + 4] * rs * g1[0] * bflo(r.z), o[8 * j + 5] * rs * g1[1] * bfhi(r.z)); w.w = cvtpk(o[8 * j + 6] * rs * g1[2] * bflo(r.w), o[8 * j + 7] * rs * g1[3] * bfhi(r.w));
            *(u32x4*)(A2 + off + 8 * j) = w; }
    }
}
constexpr int ATT_KS = 272, ATT_VS = 320, ATT_KB = 64 * ATT_KS, ATT_VB = 64 * ATT_VS, ATT_STAGE = ATT_KB + ATT_VB;
__device__ __forceinline__ void attn_tile_of(int t, int ntw, int nb_lo, int qb, int b, int& krow0, int& mtype, int& th) {
    if (t < ntw) { const int nb = nb_lo + (t >> 1); th = t & 1; krow0 = b * SEQ + nb * 128 + 64 * th; mtype = nb < qb ? 1 : (nb > qb ? 2 : 0); }
    else { krow0 = ML + b * CTXL + 64 * (t - ntw); mtype = 0; th = 0; }
}
__device__ __forceinline__ void ph_attn(Frame& F) {
    const bf16* Q = (const bf16*)(F.ws + WS_Q); const bf16* Kg = (const bf16*)(F.ws + WS_K); const bf16* Vg = (const bf16*)(F.ws + WS_V); bf16* O = (bf16*)(F.ws + WS_O);
    const float* sink = F.in[I_SINK];
    const int lane = F.lane, w = F.wave, r32 = lane & 31, hi = lane >> 5, tid = F.tid;
    LAS unsigned char* lds = F.lds;
    const int vtr_base = (4 * hi + ((lane & 15) >> 2)) * ATT_VS + (16 * ((lane >> 4) & 1) + 4 * (lane & 3)) * 2;
#define ATT_UNIT(uid_, b_, kvh_, hp_, qb_, nb_lo_, ntw_) do { const int v2_ = (uid_) & 255, s_ = (uid_) >> 8, combo_ = v2_ >> 1, half_ = v2_ & 1; \
        b_ = combo_ >> 3; kvh_ = (combo_ >> 1) & 3; hp_ = combo_ & 1; qb_ = s_ < 8 ? half_ * 8 + s_ : 16 + half_; nb_lo_ = 0; ntw_ = 0; \
        if (qb_ < 16) { nb_lo_ = qb_ > 0 ? qb_ - 1 : 0; const int nb_hi_ = qb_ < 15 ? qb_ + 1 : 15; ntw_ = 2 * (nb_hi_ - nb_lo_ + 1); } } while (0)
#define ATT_QROW(b_, qb_) ((qb_) < 16 ? (b_) * SEQ + (qb_) * 128 + qr0 + r32 : ML + (b_) * CTXL + ((qb_) - 16) * 128 + qr0 + r32)
    const int qr0 = 32 * (w & 3), srow0 = tid >> 4, sc = tid & 15;
    bf16x8 qn[8]; u32x4 stk[2], stv[2]; bool pref = false;
    for (int uid = F.vcu; uid < 2304; uid += F.G) {
        int b, kvh, hp, qb, nb_lo, ntw; ATT_UNIT(uid, b, kvh, hp, qb, nb_lo, ntw);
        const int head = 4 * kvh + 2 * hp + (w >> 2);
        const int qrow = ATT_QROW(b, qb);
        const int NT = ntw + 4;
        bf16x8 qf[8];
        int krow0, mtype, th;
        attn_tile_of(0, ntw, nb_lo, qb, b, krow0, mtype, th);
        if (!pref) {
#pragma unroll
            for (int ks = 0; ks < 8; ++ks) qf[ks] = *(const bf16x8*)(Q + (size_t)qrow * DM + head * 128 + 16 * ks + 8 * hi);
#pragma unroll
            for (int i = 0; i < 2; ++i) { const size_t g = (size_t)(krow0 + srow0 + 32 * i) * 512 + kvh * 128 + 8 * sc; stk[i] = *(const u32x4*)(Kg + g); stv[i] = *(const u32x4*)(Vg + g); }
        } else {
#pragma unroll
            for (int ks = 0; ks < 8; ++ks) qf[ks] = qn[ks];
        }
        float m_run = sink[head] * LOG2E, l_run = 1.f;
        f32x16 ot[4];
#pragma unroll
        for (int d = 0; d < 4; ++d)
#pragma unroll
            for (int r = 0; r < 16; ++r) ot[d][r] = 0.f;
        __syncthreads();
#pragma unroll
        for (int i = 0; i < 2; ++i) { *(LAS u32x4*)(lds + (srow0 + 32 * i) * ATT_KS + 16 * sc) = stk[i]; *(LAS u32x4*)(lds + ATT_KB + (srow0 + 32 * i) * ATT_VS + 16 * sc) = stv[i]; }
        __syncthreads();
        for (int t = 0; t < NT; ++t) {
            LAS unsigned char* kb = lds + (t & 1) * ATT_STAGE; LAS unsigned char* vb = kb + ATT_KB;
            int krow1, mtype1, th1;
            if (t + 1 < NT) { attn_tile_of(t + 1, ntw, nb_lo, qb, b, krow1, mtype1, th1);
#pragma unroll
                for (int i = 0; i < 2; ++i) { const size_t g = (size_t)(krow1 + srow0 + 32 * i) * 512 + kvh * 128 + 8 * sc; stk[i] = *(const u32x4*)(Kg + g); stv[i] = *(const u32x4*)(Vg + g); } }
            else { pref = uid + F.G < 2304;
                if (pref) { int b2, kvh2, hp2, qb2, nbl2, ntw2; ATT_UNIT(uid + F.G, b2, kvh2, hp2, qb2, nbl2, ntw2); int kr2, mt2, th2; attn_tile_of(0, ntw2, nbl2, qb2, b2, kr2, mt2, th2);
                    const int head2 = 4 * kvh2 + 2 * hp2 + (w >> 2), qrow2 = ATT_QROW(b2, qb2);
#pragma unroll
                    for (int ks = 0; ks < 8; ++ks) qn[ks] = *(const bf16x8*)(Q + (size_t)qrow2 * DM + head2 * 128 + 16 * ks + 8 * hi);
#pragma unroll
                    for (int i = 0; i < 2; ++i) { const size_t g = (size_t)(kr2 + srow0 + 32 * i) * 512 + kvh2 * 128 + 8 * sc; stk[i] = *(const u32x4*)(Kg + g); stv[i] = *(const u32x4*)(Vg + g); } } }
            const bool act = !((mtype == 1 && th == 0 && (w & 3) >= 2) || (mtype == 2 && th == 1 && (w & 3) <= 1));
            if (act) {
            f32x16 p0, p1;
#pragma unroll
            for (int r = 0; r < 16; ++r) { p0[r] = 0.f; p1[r] = 0.f; }
#pragma unroll
            for (int ks = 0; ks < 8; ++ks) {
                const bf16x8 a0 = *(const LAS bf16x8*)(kb + r32 * ATT_KS + (16 * ks + 8 * hi) * 2);
                const bf16x8 a1 = *(const LAS bf16x8*)(kb + (32 + r32) * ATT_KS + (16 * ks + 8 * hi) * 2);
                p0 = MFMA32(a0, qf[ks], p0); p1 = MFMA32(a1, qf[ks], p1);
            }
            if (mtype == 1) { asm volatile("" ::: "memory");
                const int d = qr0 + r32 - 64 * th - 4 * hi; const float NEG = -__builtin_inff();
#pragma unroll
                for (int r = 0; r < 16; ++r) { const int c = (r & 3) + 8 * (r >> 2); p0[r] = (c >= d) ? p0[r] : NEG; p1[r] = (c + 32 >= d) ? p1[r] : NEG; }
            } else if (mtype == 2) { asm volatile("" ::: "memory");
                const int d = qr0 + r32 - 64 * th - 4 * hi; const float NEG = -__builtin_inff();
#pragma unroll
                for (int r = 0; r < 16; ++r) { const int c = (r & 3) + 8 * (r >> 2); p0[r] = (c <= d) ? p0[r] : NEG; p1[r] = (c + 32 <= d) ? p1[r] : NEG; }
            }
            float mx = p0[0];
#pragma unroll
            for (int r = 1; r < 16; ++r) mx = fmaxf(mx, p0[r]);
#pragma unroll
            for (int r = 0; r < 16; ++r) mx = fmaxf(mx, p1[r]);
            mx = fmaxf(mx, __shfl_xor(mx, 32));
            const float mn = fmaxf(m_run, mx), alpha = fexp2(m_run - mn); m_run = mn;
            float ps = 0.f;
#pragma unroll
            for (int r = 0; r < 16; ++r) { p0[r] = fexp2(p0[r] - mn); p1[r] = fexp2(p1[r] - mn); ps += p0[r] + p1[r]; }
            ps += __shfl_xor(ps, 32);
            l_run = l_run * alpha + ps;
            if (__any(alpha != 1.f)) {
#pragma unroll
            for (int d = 0; d < 4; ++d)
#pragma unroll
                for (int r = 0; r < 16; ++r) ot[d][r] *= alpha; }
#pragma unroll
            for (int s4 = 0; s4 < 4; ++s4) {
                u32x4 pw;
                if (s4 == 0) { pw.x = cvtpk(p0[0], p0[1]); pw.y = cvtpk(p0[2], p0[3]); pw.z = cvtpk(p0[4], p0[5]); pw.w = cvtpk(p0[6], p0[7]); }
                if (s4 == 1) { pw.x = cvtpk(p0[8], p0[9]); pw.y = cvtpk(p0[10], p0[11]); pw.z = cvtpk(p0[12], p0[13]); pw.w = cvtpk(p0[14], p0[15]); }
                if (s4 == 2) { pw.x = cvtpk(p1[0], p1[1]); pw.y = cvtpk(p1[2], p1[3]); pw.z = cvtpk(p1[4], p1[5]); pw.w = cvtpk(p1[6], p1[7]); }
                if (s4 == 3) { pw.x = cvtpk(p1[8], p1[9]); pw.y = cvtpk(p1[10], p1[11]); pw.z = cvtpk(p1[12], p1[13]); pw.w = cvtpk(p1[14], p1[15]); }
                const bf16x8 pf = __builtin_bit_cast(bf16x8, pw);
#pragma unroll
                for (int d = 0; d < 4; ++d) {
                    const s16x4 lo = tr_read(vb + vtr_base + 16 * s4 * ATT_VS + 64 * d), hi4 = tr_read(vb + vtr_base + (16 * s4 + 8) * ATT_VS + 64 * d);
                    ot[d] = MFMA32(cat8(lo, hi4), pf, ot[d]);
                }
            }
            }
            if (t + 1 < NT) {
                LAS unsigned char* kn = lds + ((t + 1) & 1) * ATT_STAGE;
#pragma unroll
                for (int i = 0; i < 2; ++i) { *(LAS u32x4*)(kn + (srow0 + 32 * i) * ATT_KS + 16 * sc) = stk[i]; *(LAS u32x4*)(kn + ATT_KB + (srow0 + 32 * i) * ATT_VS + 16 * sc) = stv[i]; }
                krow0 = krow1; mtype = mtype1; th = th1;
            }
            __syncthreads();
        }
        const float inv = 1.f / l_run;
        bf16* orow = O + (size_t)qrow * DM + head * 128 + 4 * hi;
#pragma unroll
        for (int d = 0; d < 4; ++d)
#pragma unroll
            for (int g = 0; g < 4; ++g) { u32x2 o; o.x = cvtpk(ot[d][4 * g] * inv, ot[d][4 * g + 1] * inv); o.y = cvtpk(ot[d][4 * g + 2] * inv, ot[d][4 * g + 3] * inv);
                *(u32x2*)(orow + 32 * d + 8 * g) = o; }
    }
    __syncthreads();
#undef ATT_UNIT
#undef ATT_QROW
}
constexpr size_t WS_QD = WS_VX, WS_KD = WS_VX + 128 * MiB, WS_DD = WS_VX + 272 * MiB;
constexpr int GP_TS = 80;
__device__ __forceinline__ void ph_gprep(Frame& F) {
    const bf16* GQ = (const bf16*)(F.ws + WS_GQ); const bf16* GK = (const bf16*)(F.ws + WS_GK); const float* GU = (const float*)(F.ws + WS_GU);
    bf16* QD = (bf16*)(F.ws + WS_QD); bf16* KD = (bf16*)(F.ws + WS_KD); float* DD = (float*)(F.ws + WS_DD);
    const float* gw2 = F.in[I_GW2]; const float* gbp = F.in[I_GB];
    const int lane = F.lane, r32 = lane & 31, hi = lane >> 5;
    LAS unsigned char* KT = F.lds + F.wave * (4 * 32 * GP_TS); LAS unsigned char* QT = KT + 2 * 32 * GP_TS;
    const int gw = F.vcu * NWAVES + F.wave, NGW = F.G * NWAVES;
    for (int combo = gw & 31, part = gw >> 5, nparts = NGW >> 5; part < nparts && nparts > 0; part = nparts) {
        const int dir = combo >> 4, c0 = 64 * (combo & 15), tl = dir ? 0 : 31;
        u32x4 ph[2], pl[2]; float bias[2];
#pragma unroll
        for (int c = 0; c < 2; ++c) { float wv[8]; bias[c] = gbp[dir * 1024 + c0 + 32 * c + r32];
#pragma unroll
            for (int j = 0; j < 8; ++j) wv[j] = gw2[((size_t)dir * 16 + 8 * hi + j) * 1024 + c0 + 32 * c + r32];
#pragma unroll
            for (int j = 0; j < 4; ++j) { const unsigned hw = cvtpk(wv[2 * j], wv[2 * j + 1]); ph[c][j] = hw; pl[c][j] = cvtpk(wv[2 * j] - bflo(hw), wv[2 * j + 1] - bfhi(hw)); } }
        u32x4 lf0, lf1;
#pragma unroll
        for (int j = 0; j < 4; ++j) {
            const int sa = 8 * ((2 * j) >> 2) + 4 * hi + ((2 * j) & 3), sb2 = sa + 1;
            const bool a0 = dir ? (sa >= r32) : (sa <= r32), a1 = dir ? (sb2 >= r32) : (sb2 <= r32), c0b = dir ? (sa + 16 >= r32) : (sa + 16 <= r32), c1 = dir ? (sb2 + 16 >= r32) : (sb2 + 16 <= r32);
            lf0[j] = (a0 ? 0u : 0xBF80u) | (a1 ? 0u : 0xBF800000u); lf1[j] = (c0b ? 0u : 0xBF80u) | (c1 ? 0u : 0xBF800000u); }
        const u32x4 onesf = {0x3F803F80u, 0x3F803F80u, 0x3F803F80u, 0x3F803F80u};
        const int srow = lane >> 3, spc = lane & 7;
        const unsigned goff = (unsigned)(srow * 2048 + c0 * 2 + spc * 16);
        const int toff = (spc >> 2) * (32 * GP_TS) + srow * GP_TS + (spc & 3) * 16;
        u32x4 nk[4], nq[4]; f32x4 nu0, nu1;
        constexpr int NCH = MA / 32;
#define GP_LOAD(ch_) do { const size_t rb_ = (size_t)(ch_) * 32; const char* kp_ = (const char*)GK + rb_ * 2048; _Pragma("unroll") for (int i_ = 0; i_ < 4; ++i_) nk[i_] = *(const u32x4*)(kp_ + goff + i_ * 8 * 2048); \
            if (rb_ < (size_t)ML) { const char* qp_ = (const char*)GQ + rb_ * 2048; _Pragma("unroll") for (int i_ = 0; i_ < 4; ++i_) nq[i_] = *(const u32x4*)(qp_ + goff + i_ * 8 * 2048); } \
            const float* up_ = GU + (rb_ + r32) * 32 + 16 * dir + 8 * hi; nu0 = *(const f32x4*)up_; nu1 = *(const f32x4*)(up_ + 4); } while (0)
        int ch = part;
        if (ch < NCH) GP_LOAD(ch);
#pragma unroll 1
        for (; ch < NCH; ch += nparts) {
            const int row0 = 32 * ch; const bool isctx = row0 >= ML;
#pragma unroll
            for (int i = 0; i < 4; ++i) *(LAS u32x4*)(KT + toff + i * 8 * GP_TS) = nk[i];
            if (!isctx) {
#pragma unroll
                for (int i = 0; i < 4; ++i) *(LAS u32x4*)(QT + toff + i * 8 * GP_TS) = nq[i]; }
            u32x4 uh, ul;
            { const float uu[8] = {nu0[0], nu0[1], nu0[2], nu0[3], nu1[0], nu1[1], nu1[2], nu1[3]};
#pragma unroll
              for (int j = 0; j < 4; ++j) { const unsigned hw = cvtpk(uu[2 * j], uu[2 * j + 1]); uh[j] = hw; ul[j] = cvtpk(uu[2 * j] - bflo(hw), uu[2 * j + 1] - bfhi(hw)); } }
            if (ch + nparts < NCH) GP_LOAD(ch + nparts);
            f32x16 pre[2], bb[2], bl[2];
#pragma unroll
            for (int c = 0; c < 2; ++c) {
#pragma unroll
                for (int r = 0; r < 16; ++r) pre[c][r] = 0.f;
                pre[c] = MFMA32(__builtin_bit_cast(bf16x8, uh), __builtin_bit_cast(bf16x8, ph[c]), pre[c]); pre[c] = MFMA32(__builtin_bit_cast(bf16x8, ul), __builtin_bit_cast(bf16x8, ph[c]), pre[c]);
                pre[c] = MFMA32(__builtin_bit_cast(bf16x8, uh), __builtin_bit_cast(bf16x8, pl[c]), pre[c]); }
#pragma unroll
            for (int c = 0; c < 2; ++c)
#pragma unroll
                for (int r = 0; r < 16; ++r) { const float p = pre[c][r] + bias[c];
                    pre[c][r] = (fminf(p, 0.f) - __builtin_amdgcn_logf(1.f + fexp2(-fabsf(p) * LOG2E)) * 0.6931471805599453f) * 0.0625f; }
#pragma unroll
            for (int c = 0; c < 2; ++c) {
#pragma unroll
                for (int r = 0; r < 16; ++r) { bb[c][r] = 0.f; bl[c][r] = 0.f; }
#pragma unroll
                for (int st = 0; st < 2; ++st) { u32x4 lh, ll;
#pragma unroll
                    for (int j = 0; j < 4; ++j) { const float a = pre[c][8 * st + 2 * j], cc = pre[c][8 * st + 2 * j + 1]; const unsigned hw = cvtpk(a, cc); lh[j] = hw; ll[j] = cvtpk(a - bflo(hw), cc - bfhi(hw)); }
                    const bf16x8 lf = __builtin_bit_cast(bf16x8, st ? lf1 : lf0);
                    bb[c] = MFMA32(__builtin_bit_cast(bf16x8, lh), lf, bb[c]); bb[c] = MFMA32(__builtin_bit_cast(bf16x8, ll), lf, bb[c]);
                    bl[c] = MFMA32(__builtin_bit_cast(bf16x8, lh), __builtin_bit_cast(bf16x8, onesf), bl[c]); bl[c] = MFMA32(__builtin_bit_cast(bf16x8, ll), __builtin_bit_cast(bf16x8, onesf), bl[c]); } }
            asm volatile("s_waitcnt lgkmcnt(0)" ::: "memory");
            const int pb = r32 * GP_TS + 8 * hi;
#pragma unroll
            for (int g = 0; g < 4; ++g)
#pragma unroll
              for (int c = 0; c < 2; ++c) { float e[4];
#pragma unroll
                for (int j = 0; j < 4; ++j) e[j] = bb[c][4 * g + j] * LOG2E;
                LAS u32x2* kp = (LAS u32x2*)(KT + c * (32 * GP_TS) + pb + 16 * g); const u32x2 kw = *kp; u32x2 ko;
                ko.x = cvtpk(bflo(kw.x) * fexp2(-e[0]), bfhi(kw.x) * fexp2(-e[1])); ko.y = cvtpk(bflo(kw.y) * fexp2(-e[2]), bfhi(kw.y) * fexp2(-e[3])); *kp = ko;
                if (!isctx) { LAS u32x2* qp = (LAS u32x2*)(QT + c * (32 * GP_TS) + pb + 16 * g); const u32x2 qw = *qp; u32x2 qo;
                    qo.x = cvtpk(bflo(qw.x) * fexp2(e[0]), bfhi(qw.x) * fexp2(e[1])); qo.y = cvtpk(bflo(qw.y) * fexp2(e[2]), bfhi(qw.y) * fexp2(e[3])); *qp = qo; } }
            if (r32 == tl) {
#pragma unroll
                for (int c = 0; c < 2; ++c)
#pragma unroll
                    for (int g = 0; g < 4; ++g) { f32x4 d;
#pragma unroll
                        for (int j = 0; j < 4; ++j) d[j] = fexp2(bl[c][4 * g + j] * LOG2E);
                        *(f32x4*)(DD + ((size_t)ch * 2 + dir) * 1024 + c0 + 32 * c + 8 * g + 4 * hi) = d; } }
            asm volatile("s_waitcnt lgkmcnt(0)" ::: "memory");
            { char* kq = (char*)KD + ((size_t)dir * MA + row0) * 2048;
#pragma unroll
              for (int i = 0; i < 4; ++i) *(u32x4*)(kq + goff + i * 8 * 2048) = *(const LAS u32x4*)(KT + toff + i * 8 * GP_TS); }
            if (!isctx) { char* qq = (char*)QD + ((size_t)dir * ML + row0) * 2048;
#pragma unroll
              for (int i = 0; i < 4; ++i) *(u32x4*)(qq + goff + i * 8 * 2048) = *(const LAS u32x4*)(QT + toff + i * 8 * GP_TS); }
            asm volatile("s_waitcnt lgkmcnt(0)" ::: "memory");
        }
#undef GP_LOAD
    }
    __syncthreads();
}

constexpr int SC_QS = 528, SC_KS = 576, SC_VS = 576, SC_AS = 80;
constexpr int SC_QI = 0, SC_KI = SC_QI + 32 * SC_QS, SC_VI = SC_KI + 32 * SC_KS, SC_DI = SC_VI + 32 * SC_VS, SC_BUF = SC_DI + 1024;
constexpr int SC_ATT = 2 * SC_BUF, SC_END = SC_ATT + 32 * SC_AS;
static_assert(SC_END <= MISC_OFF, "scan LDS");
struct ScanRaw { u32x4 q0, q1, k0, k1, v0, v1; f32x4 d; };
__device__ __forceinline__ void scan_chunk_pos(int ci, int dir, int b, bool& isctx, int& row0) {
    isctx = ci < 8; const int cc = isctx ? ci : ci - 8, nch = isctx ? 8 : 64, c = dir ? nch - 1 - cc : cc;
    row0 = isctx ? ML + b * CTXL + 32 * c : b * SEQ + 32 * c;
}
#define SC_BARRIER() do { asm volatile("s_waitcnt lgkmcnt(0)" ::: "memory"); __builtin_amdgcn_s_barrier(); asm volatile("" ::: "memory"); } while (0)
#define SC_ADDR(name, base, off) int name = (base) + (off); asm volatile("" : "+v"(name))
template <int ABL>
__device__ __forceinline__ void ph_scan_t(Frame& F) {
    const bf16* QD = (const bf16*)(F.ws + WS_QD); const bf16* KD = (const bf16*)(F.ws + WS_KD); const bf16* GV = (const bf16*)(F.ws + WS_GV); const float* DD = (const float*)(F.ws + WS_DD);
    bf16* OF = (bf16*)(F.ws + ((ABL & 256) ? WS_GQ : WS_HB)); bf16* OB = (bf16*)(F.ws + ((ABL & 256) ? WS_GQ : WS_OB));
    LAS unsigned char* lds = F.lds;
    const int w = F.wave;
    for (int uid = F.vcu; uid < 256; uid += F.G) {
    const int tid = F.wave * 64 + lane_id_v();
    const int lane = tid & 63, r32 = lane & 31, hi = lane >> 5, i16 = lane & 15, g16 = (lane >> 4) & 1;
    const int trq = i16 >> 2, trp = i16 & 3, pt = tid >> 4, cg = tid & 15;
    const int kwb = SC_KI + pt * SC_KS + cg * 32, qwb = SC_QI + pt * SC_QS + cg * 32, vwb = SC_VI + pt * SC_VS + cg * 32, dwb = SC_DI + lane * 16;
    const int kab = SC_KI + (16 * ((w >> 1) & 1) + i16) * SC_KS + 16 * (lane >> 4), qab = SC_QI + (16 * (w & 1) + i16) * SC_QS + 16 * (lane >> 4);
    const int atw = SC_ATT + (16 * (w & 1) + i16) * SC_AS + (16 * ((w >> 1) & 1) + 4 * (lane >> 4)) * 2;
    const int drb = SC_DI + 16 * hi, qrb = SC_QI + r32 * SC_QS + 8 * hi, vtb = SC_VI + (8 * hi + trq) * SC_VS + (32 * w + 16 * g16 + 4 * trp) * 2, ktb = SC_KI + (8 * hi + trq) * SC_KS + (16 * g16 + 4 * trp) * 2;
    const int arb = SC_ATT + r32 * SC_AS + 16 * hi;
        const int b = uid >> 4, h = (uid >> 2) & 3, dir = (uid >> 1) & 1, sl = uid & 1;
        bf16* Od = dir ? OB : OF;
        const bf16* Qd = QD + (size_t)dir * ML * 1024; const bf16* Kd = KD + (size_t)dir * MA * 1024;
        unsigned amask = 0u;
        { const int s0 = 16 * ((w >> 1) & 1) + 4 * (lane >> 4), tt = 16 * (w & 1) + i16;
#pragma unroll
          for (int j = 0; j < 4; ++j) amask |= ((dir ? (s0 + j >= tt) : (s0 + j <= tt)) ? 1u : 0u) << j; }
        asm volatile("" : "+v"(amask));
        f32x16 S[8];
#pragma unroll
        for (int k = 0; k < 8; ++k)
#pragma unroll
            for (int r = 0; r < 16; ++r) S[k][r] = 0.f;
        if constexpr (ABL != 0) {
#pragma unroll
            for (int k = 0; k < 8; ++k) asm volatile("" : "+v"(S[k]));
        }
        ScanRaw R;
        const unsigned koff = (unsigned)(pt * 2048 + (h * 256 + 16 * cg) * 2), voff = (unsigned)(pt * 4096 + (h * 512 + sl * 256 + 16 * cg) * 2), doff = (unsigned)((h * 256 + 4 * lane) * 4);
        const unsigned ooff = (unsigned)(r32 * 4096 + (h * 512 + sl * 256 + 32 * w + 4 * hi) * 2);
#define SCAN_LOAD(cj) do { bool ic_; int r0_; scan_chunk_pos((cj), dir, b, ic_, r0_); \
            const char* kb_ = (const char*)Kd + (size_t)r0_ * 2048; R.k0 = *(const u32x4*)(kb_ + koff); R.k1 = *(const u32x4*)(kb_ + koff + 16); \
            if (!ic_) { const char* qb_ = (const char*)Qd + (size_t)r0_ * 2048; R.q0 = *(const u32x4*)(qb_ + koff); R.q1 = *(const u32x4*)(qb_ + koff + 16); } \
            const char* vb_ = (const char*)GV + (size_t)r0_ * 4096; R.v0 = *(const u32x4*)(vb_ + voff); R.v1 = *(const u32x4*)(vb_ + voff + 16); \
            if (w == 0) R.d = *(const f32x4*)((const char*)DD + ((size_t)(r0_ >> 5) * 2 + dir) * 4096 + doff); } while (0)
#define SCAN_WRITE(cj) do { bool ic_; int r0_; scan_chunk_pos((cj), dir, b, ic_, r0_); (void)r0_; const int ibo_ = ((cj) & 1) * SC_BUF; \
            SC_ADDR(ka_, kwb, ibo_); *(LAS u32x4*)(lds + ka_) = R.k0; *(LAS u32x4*)(lds + ka_ + 16) = R.k1; \
            if (!ic_) { SC_ADDR(qa_, qwb, ibo_); *(LAS u32x4*)(lds + qa_) = R.q0; *(LAS u32x4*)(lds + qa_ + 16) = R.q1; } \
            SC_ADDR(va_, vwb, ibo_); *(LAS u32x4*)(lds + va_) = R.v0; *(LAS u32x4*)(lds + va_ + 16) = R.v1; \
            if (w == 0) { SC_ADDR(da_, dwb, ibo_); *(LAS f32x4*)(lds + da_) = R.d; } } while (0)

        __syncthreads();
        SCAN_LOAD(0); SCAN_WRITE(0); SCAN_LOAD(1);
        __syncthreads();
#pragma unroll 1
        for (int ci = 0; ci < 72; ++ci) {
            bool isctx; int row0; scan_chunk_pos(ci, dir, b, isctx, row0);
            const int ibo = (ci & 1) * SC_BUF;
            if (!(ABL & 32)) { if (ci + 1 < 72) { SCAN_WRITE(ci + 1); } }
            if (!(ABL & 16)) { if (ci + 2 < 72) { SCAN_LOAD(ci + 2); } }
            if (!(ABL & 8) && !isctx && w < 4) {
                f32x4 a4 = {0.f, 0.f, 0.f, 0.f}; SC_ADDR(ka, kab, ibo); SC_ADDR(qa, qab, ibo);
#pragma unroll
                for (int k8 = 0; k8 < 8; ++k8) { const bf16x8 kf = *(const LAS bf16x8*)(lds + ka + 64 * k8); const bf16x8 qf = *(const LAS bf16x8*)(lds + qa + 64 * k8); a4 = MFMA16(kf, qf, a4); }
#pragma unroll
                for (int j = 0; j < 4; ++j) a4[j] = ((amask >> j) & 1u) ? a4[j] : 0.f;
                u32x2 o; o.x = cvtpk(a4[0], a4[1]); o.y = cvtpk(a4[2], a4[3]);
                *(LAS u32x2*)(lds + atw) = o;
            }
            if constexpr (!(ABL & 1)) { SC_ADDR(da, drb, ibo);
#pragma unroll
              for (int k = 0; k < 8; ++k)
#pragma unroll
                for (int g = 0; g < 4; ++g) { const f32x4 d4 = *(const LAS f32x4*)(lds + da + (32 * k + 8 * g) * 4);
#pragma unroll
                    for (int j = 0; j < 4; ++j) S[k][4 * g + j] *= d4[j]; } }
            f32x16 ot;
#pragma unroll
            for (int r = 0; r < 16; ++r) ot[r] = 0.f;
            if (!(ABL & 2) && !isctx) {
                SC_ADDR(qa, qrb, ibo);
#pragma unroll
                for (int k = 0; k < 8; ++k)
#pragma unroll
                    for (int s2 = 0; s2 < 2; ++s2) {
                        u32x4 sw; sw.x = cvtpk(S[k][8 * s2], S[k][8 * s2 + 1]); sw.y = cvtpk(S[k][8 * s2 + 2], S[k][8 * s2 + 3]); sw.z = cvtpk(S[k][8 * s2 + 4], S[k][8 * s2 + 5]); sw.w = cvtpk(S[k][8 * s2 + 6], S[k][8 * s2 + 7]);
                        const u32x2 qx = *(const LAS u32x2*)(lds + qa + (32 * k + 16 * s2) * 2), qc = *(const LAS u32x2*)(lds + qa + (32 * k + 16 * s2) * 2 + 16);
                        u32x4 qw; qw.x = qx.x; qw.y = qx.y; qw.z = qc.x; qw.w = qc.y;
                        ot = MFMA32(__builtin_bit_cast(bf16x8, sw), __builtin_bit_cast(bf16x8, qw), ot);
                    }
            }
            if constexpr (!(ABL & 128)) SC_BARRIER();
            bf16x8 vf[2];
            { SC_ADDR(va, vtb, ibo);
#pragma unroll
              for (int ts = 0; ts < 2; ++ts) vf[ts] = cat8(tr_read(lds + va + 16 * ts * SC_VS), tr_read(lds + va + (16 * ts + 4) * SC_VS)); }
            if (!(ABL & 64) && !isctx) {
#pragma unroll
                for (int ts = 0; ts < 2; ++ts) { const bf16x8 af = *(const LAS bf16x8*)(lds + arb + 32 * ts); ot = MFMA32(vf[ts], af, ot); }
                char* op = (char*)Od + (size_t)row0 * 4096;
#pragma unroll
                for (int g = 0; g < 4; ++g) { u32x2 o; o.x = cvtpk(ot[4 * g], ot[4 * g + 1]); o.y = cvtpk(ot[4 * g + 2], ot[4 * g + 3]); *(u32x2*)(op + ooff + 16 * g) = o; }
            }
            if ((ABL & 64) && !(ABL & 2) && !isctx) { asm volatile("" :: "v"(ot)); }
            if constexpr (!(ABL & 4)) { SC_ADDR(ka, ktb, ibo);
#pragma unroll
              for (int k = 0; k < 8; ++k)
#pragma unroll
                for (int ts = 0; ts < 2; ++ts) S[k] = MFMA32(cat8(tr_read(lds + ka + 16 * ts * SC_KS + 64 * k), tr_read(lds + ka + (16 * ts + 4) * SC_KS + 64 * k)), vf[ts], S[k]); }
            if constexpr (!(ABL & 128)) SC_BARRIER();
        }
        if constexpr (ABL != 0) {
#pragma unroll
            for (int k = 0; k < 8; ++k) asm volatile("" :: "v"(S[k]));
        }
#undef SCAN_LOAD
#undef SCAN_WRITE
    }
    __syncthreads();
}
__device__ __forceinline__ void ph_scan(Frame& F) {
    ph_scan_t<0>(F);
#ifdef SCAN_ABL
#ifndef SCAN_ABL_REP
#define SCAN_ABL_REP 1
#endif
#pragma unroll 1
    for (int rep = 0; rep < SCAN_ABL_REP; ++rep) ph_scan_t<SCAN_ABL>(F);
#endif
}
constexpr int N_PHASES = 22;
#define TAIL_PHASES(l, pb) \
    if (IN(pb)) REP(pb) { PH_BEGIN(); \
        ProbDense P; P.K = DM; P.A = (const bf16*)(ws + (l ? WS_A2 : WS_O)); P.Bt = (const bf16*)(ws + (l ? WS_WO2 : WS_WO)); P.S.init((l ? ML : MA) / 256, DM / 256, F.G, (int)blockIdx.x); \
        EpiWOut E{(bf16*)(ws + WS_VX), l ? (const float*)nullptr : F.in[I_X], F.in[I_CTX], (const bf16*)F.out, (const float*)(ws + WS_MODS) + (size_t)l * 17 * MODN}; \
        pg8::gemm_phase<EpiWOut, ProbDense, true>(F.lds, P, E, F.wave); \
    } SEAM(pb); \
    if (IN(pb + 1)) REP(pb + 1) { PH_BEGIN(); ph_ln1(F, l); } SEAM(pb + 1); \
    if (IN(pb + 2)) REP(pb + 2) { PH_BEGIN(); skinny_gemm<3>(F, (const bf16*)(ws + WS_HB), (const bf16*)(ws + WS_WR) + (size_t)l * 256 * DM, (float*)(ws + WS_LOG), 256, l ? ML : MA); \
        PH_BEGIN(); ph_topk(F, l); } SEAM(pb + 2);     \
    if (IN(pb + 4)) REP(pb + 4) { PH_BEGIN(); \
        const MoeTables Tb = moe_tables(F, l); \
        ProbGU P; P.K = DM; P.A = (const bf16*)(ws + WS_HB); P.Bt = (const bf16*)(ws + WS_WGU); P.list = (const unsigned*)(ws + WS_LIST); P.Tb = Tb; P.G = F.G; P.c = (int)blockIdx.x; \
        EpiGU E{(bf16*)(ws + WS_HID)}; \
        pg8::gemm_phase<EpiGU, ProbGU, true>(F.lds, P, E, F.wave); \
    } SEAM(pb + 4); \
    if (IN(pb + 5)) REP(pb + 5) { PH_BEGIN(); \
        const MoeTables Tb = moe_tables(F, l); \
        ProbDown P; P.K = MOEH; P.A = (const bf16*)(ws + WS_HID); P.Bt = (const bf16*)(ws + WS_WD); P.Tb = Tb; P.G = F.G; P.c = (int)blockIdx.x; \
        EpiDown E{(bf16*)(ws + WS_Y2), (const unsigned*)(ws + WS_LIST), (const float*)(ws + WS_WLIST)}; \
        pg8::gemm_phase<EpiDown, ProbDown, true>(F.lds, P, E, F.wave); \
    } SEAM(pb + 5); \
    if (IN(pb + 6)) REP(pb + 6) { PH_BEGIN(); ph_ln2(F, l); if (l == 0) ph_conv_moe(F, 1); } SEAM(pb + 6);

#define KARGS_DECL const float* i0, const float* i1, const float* i2, const float* i3, const float* i4, const float* i5, const float* i6, const float* i7, const float* i8, const float* i9, const float* i10, const float* i11, \
    const float* i12, const float* i13, const float* i14, const float* i15, const float* i16, const float* i17, const float* i18, const float* i19, const float* i20, const float* i21, const float* i22, const float* i23, \
    float* outp, unsigned char* wsp, int ph_lo, int ph_hi
__global__ void __launch_bounds__(NTHREADS, 2) fwd_kernel(KARGS_DECL) {
    const float* const inarr[24] = {i0, i1, i2, i3, i4, i5, i6, i7, i8, i9, i10, i11, i12, i13, i14, i15, i16, i17, i18, i19, i20, i21, i22, i23};
    extern __shared__ __attribute__((aligned(16))) unsigned char lds_raw[];
    Frame F;
    F.lds = (LAS unsigned char*)lds_raw;
    F.tid = threadIdx.x; F.lane = F.tid & 63; F.wave = __builtin_amdgcn_readfirstlane(F.tid >> 6);
    F.G = gridDim.x; { const int bx = blockIdx.x; F.vcu = (F.G % 8 == 0) ? (bx % 8) * (F.G / 8) + bx / 8 : bx; }
    F.in.p = inarr; F.out = outp; F.ws = wsp; F.ctl = (unsigned*)(F.ws + WS_CTL);
    for (int u = F.tid; u < (LDS_BYTES - MISC_OFF) / 4; u += NTHREADS) ((LAS unsigned*)(F.lds + MISC_OFF))[u] = 0u;
    __syncthreads();
    const int lo = ph_lo, hi = ph_hi;
    XcdBarrier bar; bar.bar = F.ctl + CW_BAR; bar.x = 0; bar.st = nullptr;
    if (hi - lo > 1) bar = xcd_barrier_post(F.ctl + CW_BAR, (volatile LAS unsigned*)(F.lds + MISC_OFF + 32), F.tid);
#ifdef ONLY_SET
#define IN(k) (((ONLY_SET >> (k)) & 1) && lo <= (k) && (k) < hi)
#else
#define IN(k) (lo <= (k) && (k) < hi)
#endif
#ifndef DUP_MASK
#define DUP_MASK 0
#endif
#ifndef DUP_REPS
#define DUP_REPS 2
#endif
#define REP(k) for (int rep_ = 0; rep_ < ((((DUP_MASK) >> (k)) & 1) ? DUP_REPS : 1); ++rep_)
#define PH_BEGIN() do { F.tid = F.wave * 64 + lane_id(); asm volatile("" : "+v"(F.tid)); F.lane = F.tid & 63; } while (0)
#ifdef EXTRA_BAR
#define SEAM(k) do { if (IN(k) && IN((k) + 1)) { xcd_barrier(bar, F.wave * 64 + lane_id()); if ((k) & 1) { xcd_barrier(bar, F.wave * 64 + lane_id()); xcd_barrier(bar, F.wave * 64 + lane_id()); } } } while (0)
#else
#define SEAM(k) do { if (IN(k) && IN((k) + 1)) xcd_barrier(bar, F.wave * 64 + lane_id()); } while (0)
#endif
    unsigned char* ws = F.ws;
    if (IN(0)) REP(0) { PH_BEGIN(); ph_mods(F); ph_conv0(F); } SEAM(0);
    if (IN(1)) REP(1) { PH_BEGIN(); ph_mod0(F); } SEAM(1);
    if (IN(2)) REP(2) { PH_BEGIN();
        ProbDense P; P.K = DM; P.A = (const bf16*)(ws + WS_HB); P.Bt = (const bf16*)(ws + WS_WQKV); P.S.init(MA / 256, NQKV / 256, F.G, (int)blockIdx.x);
        EpiQKV E{(bf16*)(ws + WS_Q), (bf16*)(ws + WS_K), (bf16*)(ws + WS_V), (const float*)(ws + WS_ROPE)};
        pg8::gemm_phase<EpiQKV, ProbDense, true>(F.lds, P, E, F.wave);
    } SEAM(2);
    if (IN(3)) REP(3) { PH_BEGIN(); ph_attn(F); } SEAM(3);
    TAIL_PHASES(0, 4)
    if (IN(11)) REP(11) { PH_BEGIN();
        skinny_gemm<1>(F, (const bf16*)(ws + WS_HB), (const bf16*)(ws + WS_WIN) + (size_t)6144 * DM, (float*)(ws + WS_GU), 32, MA);
        ProbProj P; P.K = DM; P.A = (const bf16*)(ws + WS_HB); P.Bt = (const bf16*)(ws + WS_WIN); P.S.init(ML / 256, 24, F.G, (int)blockIdx.x); P.G = F.G; P.c = (int)blockIdx.x;
        EpiProj E{(bf16*)(ws + WS_GQ), (bf16*)(ws + WS_GK), (bf16*)(ws + WS_GV), (bf16*)(ws + WS_GR), (float*)(ws + WS_GU)};
        pg8::gemm_phase<EpiProj, ProbProj, true>(F.lds, P, E, F.wave);
    } SEAM(11);
    if (IN(12)) REP(12) { PH_BEGIN(); ph_gprep(F); } SEAM(12);
    if (IN(13)) REP(13) { PH_BEGIN(); ph_scan(F); } SEAM(13);
    if (IN(14)) REP(14) { PH_BEGIN(); ph_readout(F); } SEAM(14);
    TAIL_PHASES(1, 15)
#undef IN
#undef SEAM
}

extern "C" void kernel_launch(void* const* d_in, const int* in_sizes, int n_in, void* d_out, int out_size, void* d_ws, size_t ws_size, hipStream_t stream) {
    static int grid = 0;
    if (grid == 0) {
        if (n_in != 24 || out_size != ML * DM || ws_size < WS_END) { fprintf(stderr, "kernel_launch: unexpected problem (n_in %d out %d ws %zu need %zu)\n", n_in, out_size, ws_size, (size_t)WS_END); grid = -1; return; }
        int dev = 0, cus = 0, per_cu = 0;
        if (hipGetDevice(&dev) != hipSuccess || hipDeviceGetAttribute(&cus, hipDeviceAttributeMultiprocessorCount, dev) != hipSuccess) { grid = -1; return; }
        if (hipFuncSetAttribute((const void*)fwd_kernel, hipFuncAttributeMaxDynamicSharedMemorySize, LDS_BYTES) != hipSuccess) { fprintf(stderr, "kernel_launch: hipFuncSetAttribute failed\n"); grid = -1; return; }
        if (hipOccupancyMaxActiveBlocksPerMultiprocessor(&per_cu, (const void*)fwd_kernel, NTHREADS, LDS_BYTES) != hipSuccess || per_cu < 1) { fprintf(stderr, "kernel_launch: occupancy query says %d\n", per_cu); }
        (void)hipGetLastError();
        grid = cus;
    }
    if (grid < 0) return;
    (void)hipMemsetAsync((char*)d_ws + WS_CTL, 0, CTL_ZERO_BYTES, stream);
    const float* in[24];
    for (int i = 0; i < 24; ++i) in[i] = (const float*)d_in[i];
#define KARGS(lo_, hi_) in[0], in[1], in[2], in[3], in[4], in[5], in[6], in[7], in[8], in[9], in[10], in[11], in[12], in[13], in[14], in[15], in[16], in[17], in[18], in[19], in[20], in[21], in[22], in[23], (float*)d_out, (unsigned char*)d_ws, (lo_), (hi_)
#if MK_FUSED
    hipLaunchKernelGGL(fwd_kernel, dim3(grid), dim3(NTHREADS), LDS_BYTES, stream, KARGS(0, N_PHASES));
#else
    for (int p = 0; p < N_PHASES; ++p) hipLaunchKernelGGL(fwd_kernel, dim3(grid), dim3(NTHREADS), LDS_BYTES, stream, KARGS(p, p + 1));
#endif
}
```

```cpp
#include <hip/hip_runtime.h>
#include <cstdio>
#include <cstdint>

#ifndef MK_FUSED
#define MK_FUSED 1
#endif
#ifndef MK_CHECK
#define MK_CHECK 0
#endif

#define GAS __attribute__((address_space(1)))
#define LAS __attribute__((address_space(3)))
typedef unsigned short bf16;
typedef short bf16x8 __attribute__((ext_vector_type(8)));
typedef short s16x4 __attribute__((ext_vector_type(4)));
typedef float f32x2 __attribute__((ext_vector_type(2)));
typedef float f32x4 __attribute__((ext_vector_type(4)));
typedef float f32x16 __attribute__((ext_vector_type(16)));
typedef unsigned u32x2 __attribute__((ext_vector_type(2)));
typedef unsigned u32x4 __attribute__((ext_vector_type(4)));
typedef __bf16 bf16x2_t __attribute__((ext_vector_type(2)));
typedef short v4i16_t __attribute__((ext_vector_type(4)));

constexpr int DM = 2048, NBATCH = 16, SEQ = 2048, CTXL = 256;
constexpr int ML = NBATCH * SEQ, MC = NBATCH * CTXL, MA = ML + MC;
constexpr int NQKV = 3072, NPROJ = 6400, MODN = 6 * DM, NEXP = 32, MOEH = 512;
constexpr int HD = 128, NHEAD = 16, NKV = 4;
constexpr int GLAH = 4, GDK = 256, GDV = 512;
constexpr float ALPHA = 1.41421356237309515f;
constexpr float LN_EPS = 1e-5f, RMS_EPS = 1e-6f;
constexpr float LOG2E = 1.4426950408889634f;
constexpr float QSCALE = 0.08838834764831845f * LOG2E;

constexpr size_t MiB = 1u << 20;
constexpr size_t WS_CTL = 0, CTL_ZERO_BYTES = 16 * 1024;
constexpr size_t WS_MODS = 1 * MiB;
constexpr size_t WS_ROPE = 3 * MiB;
constexpr size_t WS_WQKV = 4 * MiB, WS_WO = 16 * MiB, WS_WIN = 24 * MiB, WS_WO2 = 50 * MiB, WS_WR = 58 * MiB;
constexpr size_t WS_WGU = 60 * MiB, WS_WD = 188 * MiB;
constexpr size_t WS_VX = 252 * MiB;
constexpr size_t WS_HB = 540 * MiB;
constexpr size_t WS_R1 = 684 * MiB;
constexpr size_t WS_Q = WS_R1, WS_K = WS_R1 + 144 * MiB, WS_V = WS_R1 + 180 * MiB, WS_O = WS_R1 + 216 * MiB;
constexpr size_t WS_GQ = WS_R1, WS_GK = WS_R1 + 64 * MiB, WS_A2 = WS_R1, WS_GV = WS_R1 + 136 * MiB, WS_GR = WS_R1 + 280 * MiB, WS_GU = WS_R1 + 408 * MiB, WS_OB = WS_R1 + 413 * MiB;
constexpr size_t WS_LOG = WS_R1, WS_LIST = WS_R1 + 36 * MiB, WS_WLIST = WS_R1 + 45 * MiB, WS_HID = WS_R1 + 56 * MiB, WS_Y2 = WS_R1 + 136 * MiB;
constexpr size_t WS_END = WS_R1 + 541 * MiB;
constexpr int LISTCAP = 2 * MA;
constexpr int CW_TMO = 0, CW_CODE = 1;
constexpr int CW_BAR = 32;
constexpr int CW_STRIDE = 32;
constexpr int CW_CNT = 1664;
constexpr int CW_WQ = 1664 + 64 * 32;
static_assert((CW_WQ + 32) * 4 <= (int)CTL_ZERO_BYTES, "control words");

constexpr int RING_BYTES = 131072;
constexpr int MISC_OFF = 139264;
constexpr int LDS_BYTES = 147456;
constexpr int NWAVES = 8, NTHREADS = 512;

#define RLX_AGENT __ATOMIC_RELAXED, __HIP_MEMORY_SCOPE_AGENT
#define LDS_WAIT() asm volatile("s_waitcnt lgkmcnt(0)" ::: "memory")
#define VM_WAIT() asm volatile("s_waitcnt vmcnt(0)" ::: "memory")

__device__ __forceinline__ unsigned cvtpk(float lo, float hi) { f32x2 v = {lo, hi}; bf16x2_t b = __builtin_convertvector(v, bf16x2_t); return __builtin_bit_cast(unsigned, b); }
__device__ __forceinline__ float bf2f(unsigned short b) { return __uint_as_float(((unsigned)b) << 16); }
__device__ __forceinline__ float bflo(unsigned w) { return __uint_as_float(w << 16); }
__device__ __forceinline__ float bfhi(unsigned w) { return __uint_as_float(w & 0xffff0000u); }
__device__ __forceinline__ unsigned short f2bf(float f) { return (unsigned short)(cvtpk(f, 0.f) & 0xffffu); }
__device__ __forceinline__ float fexp2(float x) { return __builtin_amdgcn_exp2f(x); }
__device__ __forceinline__ float frcp(float x) { return __builtin_amdgcn_rcpf(x); }
__device__ __forceinline__ float silu_f(float x) { return x * frcp(1.f + fexp2(-x * LOG2E)); }
__device__ __forceinline__ float wave_sum(float v) {
#pragma unroll
    for (int o = 1; o < 64; o <<= 1) v += __shfl_xor(v, o);
    return v;
}
__device__ __forceinline__ int lane_id() { return (int)__builtin_amdgcn_mbcnt_hi(~0u, __builtin_amdgcn_mbcnt_lo(~0u, 0u)); }
__device__ __forceinline__ int lane_id_v() { int l; asm volatile("v_mbcnt_lo_u32_b32 %0, -1, 0\n\tv_mbcnt_hi_u32_b32 %0, -1, %0" : "=v"(l)); return l; }
__device__ __forceinline__ int crow(int r, int hi) { return (r & 3) + 8 * (r >> 2) + 4 * hi; }
__device__ __forceinline__ s16x4 tr_read(const LAS void* p) { return __builtin_bit_cast(s16x4, __builtin_amdgcn_ds_read_tr16_b64_v4i16((LAS v4i16_t*)p)); }
__device__ __forceinline__ bf16x8 cat8(s16x4 a, s16x4 b) { return __builtin_shufflevector(a, b, 0, 1, 2, 3, 4, 5, 6, 7); }
#define MFMA32(a, b, c) __builtin_amdgcn_mfma_f32_32x32x16_bf16((a), (b), (c), 0, 0, 0)
#define MFMA16(a, b, c) __builtin_amdgcn_mfma_f32_16x16x32_bf16((a), (b), (c), 0, 0, 0)

#define XB_TMO      0
#define XB_XCNT(j)  (32   + 32 * (j))
#define XB_XSUB(j)  (544  + 32 * (j))
#define XB_XGEN(j)  (1056 + 32 * (j))
#define XB_TOP      1568
#define XB_TOPGEN   1600
#define XCD_BAR_WORDS 1632
#define XB_SPIN_CAP (1u << 18)
__device__ __forceinline__ unsigned xb_ld(unsigned* p)              { return __hip_atomic_load(p, __ATOMIC_RELAXED, __HIP_MEMORY_SCOPE_AGENT); }
__device__ __forceinline__ unsigned xb_add(unsigned* p, unsigned v) { return __hip_atomic_fetch_add(p, v, __ATOMIC_RELAXED, __HIP_MEMORY_SCOPE_AGENT); }
__device__ __forceinline__ unsigned xb_xcc_id() { return (unsigned)__builtin_amdgcn_s_getreg((3 << 11) | 20) & 0xFu; }
#define XB_SPIN(cond, bar) do { unsigned _sp = 0; while (cond) { __builtin_amdgcn_s_sleep(1); \
    if ((++_sp & 255u) == 0u) { if (xb_ld(&(bar)[XB_TMO])) break; if (_sp > XB_SPIN_CAP) { atomicAdd(&(bar)[XB_TMO], 1u); break; } } } } while (0)
struct XcdBarrier { unsigned* bar; unsigned x; volatile LAS unsigned* st; };
__device__ __forceinline__ XcdBarrier xcd_barrier_post(unsigned* bar, volatile LAS unsigned* st, int tid) {
    XcdBarrier b; b.bar = bar; b.x = xb_xcc_id(); b.st = st;
    if (tid == 0) (void)xb_add(&bar[XB_XCNT(b.x)], 1u);
    return b;
}
__device__ __forceinline__ void xcd_barrier_complete(unsigned* bar, unsigned x, unsigned& nloc, unsigned& nx) {
    const unsigned G = gridDim.x * gridDim.y * gridDim.z;
    unsigned sum, cnt, mine, sp = 0u;
    for (;;) {
        sum = 0u; cnt = 0u; mine = 0u;
#pragma unroll
        for (unsigned j = 0; j < 16; ++j) { const unsigned c = xb_ld(&bar[XB_XCNT(j)]); sum += c; cnt += (c > 0u) ? 1u : 0u; mine = (j == x) ? c : mine; }
        if (sum == G) break;
        __builtin_amdgcn_s_sleep(1);
        if ((++sp & 255u) == 0u) { if (xb_ld(&bar[XB_TMO])) break; if (sp > XB_SPIN_CAP) { atomicAdd(&bar[XB_TMO], 1u); break; } }
    }
    nloc = mine > 0u ? mine : 1u; nx = cnt > 0u ? cnt : 1u;
}
__device__ __forceinline__ void xcd_barrier(const XcdBarrier& b, int tid) {
    asm volatile("s_waitcnt vmcnt(0)" ::: "memory");
    __syncthreads();
    if (tid == 0) {
        unsigned* bar = b.bar;
        __builtin_amdgcn_s_waitcnt(0);
        unsigned nloc = b.st[0], nx = b.st[1];
        if (nloc == 0u) { xcd_barrier_complete(bar, b.x, nloc, nx); b.st[0] = nloc; b.st[1] = nx; }
        const unsigned old = xb_add(&bar[XB_XSUB(b.x)], 1u);
        const unsigned gen = old / nloc;
        if (old + 1u == (gen + 1u) * nloc) {
            __builtin_amdgcn_fence(__ATOMIC_RELEASE, "agent");
            asm volatile("s_waitcnt vmcnt(0)" ::: "memory");
            const unsigned og = xb_add(&bar[XB_TOP], 1u);
            const unsigned tg = og / nx;
            __builtin_amdgcn_fence(__ATOMIC_ACQUIRE, "agent");
            if (og + 1u == (tg + 1u) * nx) xb_add(&bar[XB_TOPGEN], 1u);
            else XB_SPIN(xb_ld(&bar[XB_TOPGEN]) == tg, bar);
            asm volatile("s_waitcnt vmcnt(0)" ::: "memory");
        } else {
            __builtin_amdgcn_fence(__ATOMIC_ACQUIRE, "agent");
            XB_SPIN(xb_ld(&bar[XB_TOPGEN]) == gen, bar);
            asm volatile("s_waitcnt vmcnt(0)" ::: "memory");
        }
    }
    __syncthreads();
}

struct Args { const float* in[24]; float* out; unsigned char* ws; int ph_lo, ph_hi, li, pad; };
enum { I_X = 0, I_C, I_CTX, I_CCTX, I_MODW, I_MODB, I_LNG, I_LNB, I_WQKV, I_WOA, I_SINK, I_WIN, I_GW1, I_GW2, I_GB, I_NG, I_WOG, I_MGW, I_MGB, I_MRW, I_MRB, I_MWG, I_MWU, I_MWD };
struct InPtrs { const float* const* p; __device__ __forceinline__ const float* operator[](int i) const { return p[i]; } };
struct Frame {
    LAS unsigned char* lds;
    unsigned* ctl;
    int tid, lane, wave, vcu, G;
    InPtrs in; float* out; unsigned char* ws;
};
__device__ __forceinline__ const float* mods_ptr(const Frame& F, int l, int mr, int chunk) { return (const float*)(F.ws + WS_MODS) + ((size_t)(l * 17 + mr) * MODN + chunk * DM); }
__device__ __forceinline__ int mod_row(int m) { return m < ML ? (m >> 11) : 16; }
namespace pg8 {
constexpr int BM = 256, BK = 64, HALF = 128, HTB = HALF * BK * 2, STAGE_BYTES = 8 * HTB, NXCD = 8, WGM = 8;
__host__ __device__ __forceinline__ int lds_byte(int r, int c) { const int st = (r >> 4) * 2 + (c >> 5), rr = r & 15, cc = c & 31, ob = rr * 64 + cc * 2; return st * 1024 + (ob ^ (((ob >> 9) & 1) << 5)); }
__host__ __device__ __forceinline__ void stage_rc(int b, int& R, int& C) { const int st = b / 1024, sb = b % 1024, swz = sb ^ (((sb >> 9) & 1) << 5); R = (st >> 1) * 16 + swz / 64; C = (st & 1) * 32 + (swz % 64) / 2; }
__host__ __device__ __forceinline__ int perm32(int rho) { const int n = rho >> 4, i = rho & 15; return 8 * (i >> 2) + 4 * n + (i & 3); }

struct Unit { int pm, pn, e, lrow0, valid; };

struct StaticOrder {
    int nM, nN, nwg, G, c;
    __device__ void init(int nM_, int nN_, int G_, int c_) { nM = nM_; nN = nN_; nwg = nM * nN; G = G_; c = c_; }
    __device__ bool map(int i, int& pm, int& pn) const {
        const long L = (long)i * G + c; if (L >= nwg) return false;
        int wgid = (int)L; { const int q = nwg / NXCD, r = nwg % NXCD, xcd = wgid % NXCD, off = wgid / NXCD; wgid = (xcd < r ? xcd * (q + 1) : r * (q + 1) + (xcd - r) * q) + off; }
        const int nig = WGM * nN, gid = wgid / nig, fm = gid * WGM, gsz = (nM - fm) < WGM ? (nM - fm) : WGM;
        pm = fm + ((wgid % nig) % gsz); pn = (wgid % nig) / gsz; return true;
    }
};

template <class Epi, class Prob, bool ALIGN_EPI>
__device__ __forceinline__ void gemm_phase(LAS unsigned char* lds, const Prob& P, const Epi& E, int wave) {
    const int wid = wave, lane = lane_id(), tid = wid * 64 + lane, wr = wid >> 2, wc = wid & 3, fr = lane & 15, fq = lane >> 4;
    const int K = P.K, nt = K / BK;
    unsigned voffB[2][2];
#pragma unroll
    for (int i = 0; i < 2; ++i) { int R, C; stage_rc(tid * 16 + i * 8192, R, C); const int Rb = Epi::PERM ? ((R & ~31) + perm32(R & 31)) : R;
        voffB[0][i] = (unsigned)(Rb * K + C) * 2u; voffB[1][i] = (unsigned)((Rb + HALF) * K + C) * 2u; }
    const size_t kstep = (size_t)(BK * 2);
    const unsigned ldsw = (unsigned)wid * 1024u;
    const int aoff = lds_byte(wr * 64 + fr, fq * 8), boff = lds_byte(wc * 32 + fr, fq * 8);
#define PG8_SA(b, h) (((b) * 2 + (h)) * HTB)
#define PG8_SB(b, h) ((4 + (b) * 2 + (h)) * HTB)
#define PG8_STAGE(bufoff, gbase, v0, v1) do { \
        __builtin_amdgcn_global_load_lds((const unsigned*)((const char*)(gbase) + (v0)), (LAS unsigned*)(lds + (bufoff) + ldsw), 16, 0, 0); \
        __builtin_amdgcn_global_load_lds((const unsigned*)((const char*)(gbase) + (v1)), (LAS unsigned*)(lds + (bufoff) + ldsw + 8192), 16, 0, 0); } while (0)
#define PG8_LDA(dst, b, h) do { _Pragma("unroll") for (int m = 0; m < 4; ++m) _Pragma("unroll") for (int k = 0; k < 2; ++k) dst[m][k] = *(const LAS bf16x8*)(lds + PG8_SA(b, h) + aoff + m * 2048 + k * 1024); } while (0)
#define PG8_LDB(dst, b, h) do { _Pragma("unroll") for (int n = 0; n < 2; ++n) _Pragma("unroll") for (int k = 0; k < 2; ++k) dst[n][k] = *(const LAS bf16x8*)(lds + PG8_SB(b, h) + boff + n * 2048 + k * 1024); } while (0)
#define PG8_MMA(ai, bj, At, Bt) do { __builtin_amdgcn_s_setprio(1); _Pragma("unroll") for (int m = 0; m < 4; ++m) _Pragma("unroll") for (int n = 0; n < 2; ++n) _Pragma("unroll") for (int k = 0; k < 2; ++k) \
        acc[ai][bj][m][n] = __builtin_amdgcn_mfma_f32_16x16x32_bf16(Bt[n][k], At[m][k], acc[ai][bj][m][n], 0, 0, 0); __builtin_amdgcn_s_setprio(0); } while (0)
#define PG8_WAIT_V(n) asm volatile("s_waitcnt vmcnt(" #n ")" ::: "memory")
#define PG8_WAIT_L(n) asm volatile("s_waitcnt lgkmcnt(" #n ")" ::: "memory")
#define PG8_BAR __builtin_amdgcn_s_barrier()
#define PG8_SCHED __builtin_amdgcn_sched_barrier(0)
    Unit cur, nxt; int ui = 0;
    if (!P.next(0, cur)) return;
    f32x4 acc[2][2][4][2];
#pragma unroll
    for (int a = 0; a < 2; ++a)
#pragma unroll
        for (int b = 0; b < 2; ++b)
#pragma unroll
            for (int m = 0; m < 4; ++m)
#pragma unroll
                for (int n = 0; n < 2; ++n) acc[a][b][m][n] = (f32x4){0.f, 0.f, 0.f, 0.f};
    bf16x8 At[4][2], B0[2][2], B1[2][2];
    const char* cA; const char* nA; unsigned cva[2][2], nva[2][2];
    P.a_setup(cur, cA, cva, tid);
    const char* cB = P.b_base(cur); const char* nB;
    PG8_STAGE(PG8_SB(0, 0), cB, voffB[0][0], voffB[0][1]); PG8_STAGE(PG8_SB(0, 1), cB, voffB[1][0], voffB[1][1]); PG8_STAGE(PG8_SA(0, 0), cA, cva[0][0], cva[0][1]); PG8_STAGE(PG8_SA(0, 1), cA, cva[1][0], cva[1][1]);
    if (wr == 1) PG8_BAR;
    PG8_WAIT_V(2); PG8_BAR;
    PG8_STAGE(PG8_SB(1, 0), cB + kstep, voffB[0][0], voffB[0][1]); PG8_STAGE(PG8_SA(1, 0), cA + kstep, cva[0][0], cva[0][1]); PG8_STAGE(PG8_SB(1, 1), cB + kstep, voffB[1][0], voffB[1][1]);
    PG8_WAIT_V(6); PG8_BAR;
    for (;;) {
        const bool has_next = P.next(ui + 1, nxt);
        nA = cA; nB = cB;
        if constexpr (Prob::GATHER) {
#pragma unroll
        for (int h = 0; h < 2; ++h)
#pragma unroll
            for (int i = 0; i < 2; ++i) nva[h][i] = cva[h][i]; }
        for (int t = 0; t < nt; t += 2) {
            const bool last = (t == nt - 2);
            if (last && has_next) { if constexpr (Prob::GATHER) P.a_setup(nxt, nA, nva, tid); else nA = P.a_base(nxt); nB = P.b_base(nxt); }
            const char* a1 = cA + (size_t)(t + 1) * kstep;
            const char* a2 = last ? nA : cA + (size_t)(t + 2) * kstep; const char* b2 = last ? nB : cB + (size_t)(t + 2) * kstep;
            const char* a3 = a2 + kstep; const char* b3 = b2 + kstep;
            unsigned x00 = cva[0][0], x01 = cva[0][1], x10 = cva[1][0], x11 = cva[1][1];
            if constexpr (Prob::GATHER) { x00 = last ? nva[0][0] : x00; x01 = last ? nva[0][1] : x01; x10 = last ? nva[1][0] : x10; x11 = last ? nva[1][1] : x11; }
            PG8_LDB(B0, 0, 0); PG8_LDB(B1, 0, 1); PG8_SCHED; PG8_LDA(At, 0, 0); PG8_STAGE(PG8_SA(1, 1), a1, cva[1][0], cva[1][1]);
            PG8_WAIT_V(8); PG8_WAIT_L(0); PG8_BAR; PG8_MMA(0, 0, At, B0); PG8_MMA(0, 1, At, B1); PG8_BAR; PG8_SCHED;
            PG8_LDA(At, 0, 1); PG8_STAGE(PG8_SB(0, 0), b2, voffB[0][0], voffB[0][1]); PG8_STAGE(PG8_SB(0, 1), b2, voffB[1][0], voffB[1][1]); PG8_STAGE(PG8_SA(0, 0), a2, x00, x01);
            PG8_WAIT_V(8); PG8_WAIT_L(0); PG8_BAR; PG8_MMA(1, 0, At, B0); PG8_MMA(1, 1, At, B1); PG8_BAR; PG8_SCHED;
            PG8_LDB(B0, 1, 0); PG8_LDB(B1, 1, 1); PG8_SCHED; PG8_LDA(At, 1, 0); PG8_STAGE(PG8_SA(0, 1), a2, x10, x11);
            PG8_WAIT_V(8); PG8_WAIT_L(0); PG8_BAR; PG8_MMA(0, 0, At, B0); PG8_MMA(0, 1, At, B1); PG8_BAR; PG8_SCHED;
            PG8_LDA(At, 1, 1); PG8_STAGE(PG8_SB(1, 0), b3, voffB[0][0], voffB[0][1]); PG8_STAGE(PG8_SB(1, 1), b3, voffB[1][0], voffB[1][1]); PG8_STAGE(PG8_SA(1, 0), a3, x00, x01);
            PG8_WAIT_V(8); PG8_WAIT_L(0); PG8_BAR; PG8_MMA(1, 0, At, B0); PG8_MMA(1, 1, At, B1); PG8_BAR; PG8_SCHED;
        }
        if constexpr (ALIGN_EPI) { if (wr == 0) PG8_BAR; }
        E(acc, cur, wr, wc, fr, fq);
        if (!has_next) break;
#pragma unroll
        for (int a = 0; a < 2; ++a)
#pragma unroll
            for (int b = 0; b < 2; ++b)
#pragma unroll
                for (int m = 0; m < 4; ++m)
#pragma unroll
                    for (int n = 0; n < 2; ++n) acc[a][b][m][n] = (f32x4){0.f, 0.f, 0.f, 0.f};
        cur = nxt; cA = nA; cB = nB; ++ui;
        if constexpr (Prob::GATHER) {
#pragma unroll
        for (int h = 0; h < 2; ++h)
#pragma unroll
            for (int i = 0; i < 2; ++i) cva[h][i] = nva[h][i]; }
        if constexpr (ALIGN_EPI) { if (wr == 1) PG8_BAR; }
    }
    PG8_WAIT_V(0);
    if constexpr (!ALIGN_EPI) { if (wr == 0) PG8_BAR; }
    PG8_BAR;
#undef PG8_SA
#undef PG8_SB
#undef PG8_STAGE
#undef PG8_LDA
#undef PG8_LDB
#undef PG8_MMA
#undef PG8_WAIT_V
#undef PG8_WAIT_L
#undef PG8_BAR
#undef PG8_SCHED
}

__device__ __forceinline__ void dense_offsets(int K, unsigned (&va)[2][2], int tid) {
#pragma unroll
    for (int i = 0; i < 2; ++i) { int R, C; stage_rc(tid * 16 + i * 8192, R, C); va[0][i] = (unsigned)(R * K + C) * 2u; va[1][i] = (unsigned)((R + HALF) * K + C) * 2u; }
}
}
struct ProbDense {
    int K; const bf16* A; const bf16* Bt; pg8::StaticOrder S;
    __device__ __forceinline__ bool next(int i, pg8::Unit& u) const { u.e = 0; u.lrow0 = 0; u.valid = 256; return S.map(i, u.pm, u.pn); }
    static constexpr bool GATHER = false;
    __device__ __forceinline__ const char* a_base(const pg8::Unit& u) const { return (const char*)(A + (size_t)u.pm * 256 * K); }
    __device__ __forceinline__ void a_setup(const pg8::Unit& u, const char*& base, unsigned (&va)[2][2], int tid) const { base = a_base(u); pg8::dense_offsets(K, va, tid); }
    __device__ __forceinline__ const char* b_base(const pg8::Unit& u) const { return (const char*)(Bt + (size_t)u.pn * 256 * K); }
};

struct EpiQKV {
    static constexpr bool PERM = true;
    bf16* Q; bf16* Kb; bf16* Vb; const float* cs;
    __device__ __forceinline__ void operator()(const f32x4 (&acc)[2][2][4][2], const pg8::Unit& u, int wr, int wc, int fr_, int fq_) const {
        int fr = fr_, fq = fq_; asm volatile("" : "+v"(fr), "+v"(fq));
        const int row0 = u.pm * 256 + wr * 64 + fr;
        bf16* dst; int ldc, colt; float sc = 1.f; bool rope = (u.pm < ML / 256);
        if (u.pn < 8) { dst = Q; ldc = DM; colt = u.pn * 256; sc = QSCALE; }
        else if (u.pn < 10) { dst = Kb; ldc = 512; colt = (u.pn - 8) * 256; }
        else { dst = Vb; ldc = 512; colt = (u.pn - 10) * 256; rope = false; }
        const int p0 = wc * 32 + fq * 8;
        const int i0 = (p0 & 63) >> 1;
#pragma unroll
        for (int ai = 0; ai < 2; ++ai) {
            f32x4 ca[4], cb[4];
#pragma unroll
            for (int m = 0; m < 4; ++m) { const int row = row0 + ai * 128 + m * 16, t = row & (SEQ - 1), pos = (wc < 2) ? (t >> 6) : (t & 63);
                ca[m] = (f32x4){1.f, 0.f, 1.f, 0.f}; cb[m] = ca[m];
                if (rope) { const f32x4* cp = (const f32x4*)(cs + (size_t)(pos * 32 + i0) * 2); ca[m] = cp[0]; cb[m] = cp[1]; } }
#pragma unroll
            for (int m = 0; m < 4; ++m) {
                const int row = row0 + ai * 128 + m * 16;
                bf16* rowp = dst + (size_t)row * ldc + colt + wc * 32 + fq * 8;
#pragma unroll
                for (int bj = 0; bj < 2; ++bj) {
                    const f32x4 v0 = acc[ai][bj][m][0], v1 = acc[ai][bj][m][1];
                    const float o0 = (v0[0] * ca[m][0] - v0[1] * ca[m][1]) * sc, o1 = (v0[1] * ca[m][0] + v0[0] * ca[m][1]) * sc;
                    const float o2 = (v0[2] * ca[m][2] - v0[3] * ca[m][3]) * sc, o3 = (v0[3] * ca[m][2] + v0[2] * ca[m][3]) * sc;
                    const float o4 = (v1[0] * cb[m][0] - v1[1] * cb[m][1]) * sc, o5 = (v1[1] * cb[m][0] + v1[0] * cb[m][1]) * sc;
                    const float o6 = (v1[2] * cb[m][2] - v1[3] * cb[m][3]) * sc, o7 = (v1[3] * cb[m][2] + v1[2] * cb[m][3]) * sc;
                    u32x4 w; w.x = cvtpk(o0, o1); w.y = cvtpk(o2, o3); w.z = cvtpk(o4, o5); w.w = cvtpk(o6, o7);
                    *(u32x4*)(rowp + bj * 128) = w;
                }
            }
            asm volatile("" ::: "memory");
        }
    }
};

struct EpiWOut {
    static constexpr bool PERM = true;
    bf16* V; const float* xl; const float* xc; const bf16* xb; const float* mods;
    __device__ __forceinline__ void operator()(const f32x4 (&acc)[2][2][4][2], const pg8::Unit& u, int wr, int wc, int fr_, int fq_) const {
        int fr = fr_, fq = fq_; asm volatile("" : "+v"(fr), "+v"(fq));
        const int row0 = u.pm * 256 + wr * 64 + fr, col0 = u.pn * 256 + wc * 32 + 8 * fq;
        const int mr = u.pm < ML / 256 ? (u.pm >> 3) : 16;
        const float* g1 = mods + (size_t)mr * MODN + 2 * DM + col0;
        f32x4 gv[2][2];
#pragma unroll
        for (int bj = 0; bj < 2; ++bj)
#pragma unroll
            for (int n = 0; n < 2; ++n) gv[bj][n] = *(const f32x4*)(g1 + bj * 128 + n * 4);
#pragma unroll
        for (int ai = 0; ai < 2; ++ai) {
            f32x4 xr0[4][2], xr1[4][2];
#pragma unroll
            for (int m = 0; m < 4; ++m) { const int row = row0 + ai * 128 + m * 16;
#pragma unroll
                for (int bj = 0; bj < 2; ++bj) {
                    if (xl) { const float* xr = (row < ML ? xl + (size_t)row * DM : xc + (size_t)(row - ML) * DM) + col0 + bj * 128; xr0[m][bj] = *(const f32x4*)xr; xr1[m][bj] = *(const f32x4*)(xr + 4); }
                    else { const u32x4 xw = *(const u32x4*)(xb + (size_t)row * DM + col0 + bj * 128); xr0[m][bj] = (f32x4){bflo(xw.x), bfhi(xw.x), bflo(xw.y), bfhi(xw.y)}; xr1[m][bj] = (f32x4){bflo(xw.z), bfhi(xw.z), bflo(xw.w), bfhi(xw.w)}; } } }
#pragma unroll
            for (int m = 0; m < 4; ++m) { const int row = row0 + ai * 128 + m * 16; bf16* vr = V + (size_t)row * DM + col0;
#pragma unroll
                for (int bj = 0; bj < 2; ++bj) {
                    const f32x4 v0 = xr0[m][bj] * ALPHA + gv[bj][0] * acc[ai][bj][m][0], v1 = xr1[m][bj] * ALPHA + gv[bj][1] * acc[ai][bj][m][1];
                    u32x4 o; o.x = cvtpk(v0[0], v0[1]); o.y = cvtpk(v0[2], v0[3]); o.z = cvtpk(v1[0], v1[1]); o.w = cvtpk(v1[2], v1[3]);
                    *(u32x4*)(vr + bj * 128) = o; } }
            asm volatile("" ::: "memory");
        }
    }
};

struct EpiF32 {
    static constexpr bool PERM = false;
    float* C; int ldc;
    __device__ __forceinline__ void operator()(const f32x4 (&acc)[2][2][4][2], const pg8::Unit& u, int wr, int wc, int fr_, int fq_) const {
        int fr = fr_, fq = fq_; asm volatile("" : "+v"(fr), "+v"(fq));
        const int row0 = u.pm * 256 + wr * 64 + fr, col0 = u.pn * 256 + wc * 32 + 4 * fq;
#pragma unroll
        for (int ai = 0; ai < 2; ++ai)
#pragma unroll
            for (int m = 0; m < 4; ++m) { float* rowp = C + (size_t)(row0 + ai * 128 + m * 16) * ldc + col0;
#pragma unroll
                for (int bj = 0; bj < 2; ++bj)
#pragma unroll
                    for (int n = 0; n < 2; ++n) *(f32x4*)(rowp + bj * 128 + n * 16) = acc[ai][bj][m][n]; }
    }
};

struct MoeTables { const LAS int* toff; const LAS int* cnt; };
__device__ __forceinline__ bool moe_unit(const MoeTables& Tb, long L, int nct, pg8::Unit& u) {
    const int ntile = Tb.toff[32];
    if (L >= (long)ntile * nct) return false;
    const int rt = (int)(L / nct); u.pm = rt; u.pn = (int)(L % nct);
    int e = 0;
#pragma unroll
    for (int j = 1; j < 32; ++j) e += (rt >= Tb.toff[j]) ? 1 : 0;
    u.e = e; u.lrow0 = (rt - Tb.toff[e]) * 256; const int rem = Tb.cnt[e] - u.lrow0; u.valid = rem < 256 ? rem : 256;
    return true;
}
struct ProbGU {
    int K; const bf16* A; const bf16* Bt; const unsigned* list; MoeTables Tb; int G, c;
    __device__ __forceinline__ bool next(int i, pg8::Unit& u) const { return moe_unit(Tb, (long)i * G + c, 4, u); }
    static constexpr bool GATHER = true;
    __device__ __forceinline__ const char* a_base(const pg8::Unit&) const { return (const char*)A; }
    __device__ __forceinline__ void a_setup(const pg8::Unit& u, const char*& base, unsigned (&va)[2][2], int tid) const {
        base = (const char*)A; const unsigned* lp = list + (size_t)u.e * LISTCAP + u.lrow0;
#pragma unroll
        for (int i = 0; i < 2; ++i) { int R, C; pg8::stage_rc(tid * 16 + i * 8192, R, C);
#pragma unroll
            for (int h = 0; h < 2; ++h) { const int r = h * 128 + R; const unsigned raw = lp[r];
                const unsigned ent = (r < u.valid) ? raw : 0u; va[h][i] = ((ent >> 1) * (unsigned)K + (unsigned)C) * 2u; } }
    }
    __device__ __forceinline__ const char* b_base(const pg8::Unit& u) const { return (const char*)(Bt + ((size_t)u.e * 1024 + (size_t)u.pn * 256) * K); }
};
struct EpiGU {
    static constexpr bool PERM = true;
    bf16* HID;
    __device__ __forceinline__ void operator()(const f32x4 (&acc)[2][2][4][2], const pg8::Unit& u, int wr, int wc, int fr_, int fq_) const {
        int fr = fr_, fq = fq_; asm volatile("" : "+v"(fr), "+v"(fq));
        const int row0 = u.pm * 256 + wr * 64 + fr, col0 = u.pn * 128 + wc * 32 + fq * 8;
#pragma unroll
        for (int ai = 0; ai < 2; ++ai)
#pragma unroll
            for (int m = 0; m < 4; ++m) {
                const f32x4 g0 = acc[ai][0][m][0], g1 = acc[ai][0][m][1], u0 = acc[ai][1][m][0], u1 = acc[ai][1][m][1];
                u32x4 w; w.x = cvtpk(silu_f(g0[0]) * u0[0], silu_f(g0[1]) * u0[1]); w.y = cvtpk(silu_f(g0[2]) * u0[2], silu_f(g0[3]) * u0[3]);
                w.z = cvtpk(silu_f(g1[0]) * u1[0], silu_f(g1[1]) * u1[1]); w.w = cvtpk(silu_f(g1[2]) * u1[2], silu_f(g1[3]) * u1[3]);
                *(u32x4*)(HID + (size_t)(row0 + ai * 128 + m * 16) * MOEH + col0) = w;
            }
    }
};
struct ProbDown {
    int K; const bf16* A; const bf16* Bt; MoeTables Tb; int G, c;
    __device__ __forceinline__ bool next(int i, pg8::Unit& u) const { return moe_unit(Tb, (long)i * G + c, 8, u); }
    static constexpr bool GATHER = false;
    __device__ __forceinline__ const char* a_base(const pg8::Unit& u) const { return (const char*)(A + (size_t)u.pm * 256 * K); }
    __device__ __forceinline__ void a_setup(const pg8::Unit& u, const char*& base, unsigned (&va)[2][2], int tid) const { base = a_base(u); pg8::dense_offsets(K, va, tid); }
    __device__ __forceinline__ const char* b_base(const pg8::Unit& u) const { return (const char*)(Bt + ((size_t)u.e * DM + (size_t)u.pn * 256) * K); }
};
struct EpiDown {
    static constexpr bool PERM = true;
    bf16* Y2; const unsigned* list; const float* wlist;
    __device__ __forceinline__ void operator()(const f32x4 (&acc)[2][2][4][2], const pg8::Unit& u, int wr, int wc, int fr_, int fq_) const {
        int fr = fr_, fq = fq_; asm volatile("" : "+v"(fr), "+v"(fq));
        const int col0 = u.pn * 256 + wc * 32 + fq * 8;
        const size_t lb = (size_t)u.e * LISTCAP + u.lrow0;
        unsigned ent[8]; float wt[8];
#pragma unroll
        for (int i = 0; i < 8; ++i) { const int lr = (i >> 2) * 128 + wr * 64 + (i & 3) * 16 + fr; const bool ok = lr < u.valid; const unsigned er = list[lb + lr]; const float wr_ = wlist[lb + lr];
            ent[i] = ok ? er : 0xffffffffu; wt[i] = ok ? wr_ : 0.f; }
#pragma unroll
        for (int ai = 0; ai < 2; ++ai)
#pragma unroll
            for (int m = 0; m < 4; ++m) {
                const unsigned en = ent[ai * 4 + m]; const float w = wt[ai * 4 + m];
                if (en != 0xffffffffu) {
                    bf16* rowp = Y2 + ((size_t)(en & 1u) * MA + (en >> 1)) * DM + col0;
#pragma unroll
                    for (int bj = 0; bj < 2; ++bj) { const f32x4 v0 = acc[ai][bj][m][0] * w, v1 = acc[ai][bj][m][1] * w;
                        u32x4 o; o.x = cvtpk(v0[0], v0[1]); o.y = cvtpk(v0[2], v0[3]); o.z = cvtpk(v1[0], v1[1]); o.w = cvtpk(v1[2], v1[3]);
                        *(u32x4*)(rowp + bj * 128) = o; }
                }
            }
    }
};

struct ProbProj {
    int K; const bf16* A; const bf16* Bt; pg8::StaticOrder S; int G, c;
    __device__ __forceinline__ bool next(int i, pg8::Unit& u) const {
        u.e = 0; u.lrow0 = 0; u.valid = 256;
        if (S.map(i, u.pm, u.pn)) return true;
        const long L = (long)i * G + c - S.nwg; if (L < 0 || L >= 16 * 12) return false;
        u.pm = ML / 256 + (int)(L / 12); u.pn = 4 + (int)(L % 12); return true;
    }
    static constexpr bool GATHER = false;
    __device__ __forceinline__ const char* a_base(const pg8::Unit& u) const { return (const char*)(A + (size_t)u.pm * 256 * K); }
    __device__ __forceinline__ void a_setup(const pg8::Unit& u, const char*& base, unsigned (&va)[2][2], int tid) const { base = a_base(u); pg8::dense_offsets(K, va, tid); }
    __device__ __forceinline__ const char* b_base(const pg8::Unit& u) const { return (const char*)(Bt + (size_t)u.pn * 256 * K); }
};
struct EpiProj {
    static constexpr bool PERM = true;
    bf16* GQ; bf16* GK; bf16* GV; bf16* GR; float* GU;
    __device__ __forceinline__ void operator()(const f32x4 (&acc)[2][2][4][2], const pg8::Unit& u, int wr, int wc, int fr_, int fq_) const {
        int fr = fr_, fq = fq_; asm volatile("" : "+v"(fr), "+v"(fq));
        const int row0 = u.pm * 256 + wr * 64 + fr, cw = wc * 32 + fq * 8;
        if (u.pn == 24) {
            if (wc == 0) {
#pragma unroll
                for (int ai = 0; ai < 2; ++ai)
#pragma unroll
                    for (int m = 0; m < 4; ++m) { float* rp = GU + (size_t)(row0 + ai * 128 + m * 16) * 32 + fq * 8;
                        *(f32x4*)rp = acc[ai][0][m][0]; *(f32x4*)(rp + 4) = acc[ai][0][m][1]; }
            }
            return;
        }
        bf16* dst; int ldc, colt; bool act = false;
        if (u.pn < 4) { dst = GQ; ldc = 1024; colt = u.pn * 256; }
        else if (u.pn < 8) { dst = GK; ldc = 1024; colt = (u.pn - 4) * 256; }
        else if (u.pn < 16) { dst = GV; ldc = 2048; colt = (u.pn - 8) * 256; }
        else { dst = GR; ldc = 2048; colt = (u.pn - 16) * 256; act = true; }
#pragma unroll
        for (int ai = 0; ai < 2; ++ai)
#pragma unroll
            for (int m = 0; m < 4; ++m) { bf16* rowp = dst + (size_t)(row0 + ai * 128 + m * 16) * ldc + colt + cw;
#pragma unroll
                for (int bj = 0; bj < 2; ++bj) { f32x4 v0 = acc[ai][bj][m][0], v1 = acc[ai][bj][m][1];
                    if (act) {
#pragma unroll
                        for (int j = 0; j < 4; ++j) { v0[j] = silu_f(v0[j]); v1[j] = silu_f(v1[j]); } }
                    u32x4 o; o.x = cvtpk(v0[0], v0[1]); o.y = cvtpk(v0[2], v0[3]); o.z = cvtpk(v1[0], v1[1]); o.w = cvtpk(v1[2], v1[3]);
                    *(u32x4*)(rowp + bj * 128) = o; }
                asm volatile("" ::: "memory"); }
    }
};
__device__ __forceinline__ void ph_mods(Frame& F) {
    LAS float* S = (LAS float*)F.lds;
    const float* c = F.in[I_C]; const float* cc = F.in[I_CCTX]; const float* mw = F.in[I_MODW]; const float* mb = F.in[I_MODB];
    float* mods = (float*)(F.ws + WS_MODS);
    for (int item = blockIdx.x; item < 2 * 96; item += F.G) {
        const int l = item / 96, n0 = (item % 96) * 128;
        __syncthreads();
        for (int idx = F.tid; idx < 17 * DM; idx += NTHREADS) { const int r = idx >> 11, k = idx & (DM - 1); const float v = r < 16 ? c[r * DM + k] : cc[k]; S[idx] = v / (1.f + __expf(-v)); }
        __syncthreads();
        const int g = F.tid & 31, ks = F.tid >> 5;
        f32x4 acc[17];
#pragma unroll
        for (int r = 0; r < 17; ++r) acc[r] = (f32x4){0.f, 0.f, 0.f, 0.f};
        const float* w = mw + (size_t)l * DM * MODN + n0 + 4 * g;
#pragma unroll 4
        for (int i = 0; i < 32; ++i) { const int k = ks * 128 + 4 * i; f32x4 wv[4];
#pragma unroll
            for (int q = 0; q < 4; ++q) wv[q] = *(const f32x4*)(w + (size_t)(k + q) * MODN);
#pragma unroll
            for (int r = 0; r < 17; ++r) { const f32x4 sv = *(const LAS f32x4*)(S + r * DM + k); acc[r] += wv[0] * sv[0]; acc[r] += wv[1] * sv[1]; acc[r] += wv[2] * sv[2]; acc[r] += wv[3] * sv[3]; } }
#pragma unroll
        for (int r = 0; r < 17; ++r)
#pragma unroll
            for (int j = 0; j < 4; ++j) acc[r][j] += __shfl_xor(acc[r][j], 32);
        __syncthreads();
        LAS f32x4* red = (LAS f32x4*)F.lds;
        if (F.lane < 32) {
#pragma unroll
            for (int r = 0; r < 17; ++r) red[(F.wave * 17 + r) * 32 + g] = acc[r];
        }
        __syncthreads();
        for (int o = F.tid; o < 17 * 32; o += NTHREADS) { const int r = o >> 5, gg = o & 31; f32x4 s = *(const f32x4*)(mb + (size_t)l * MODN + n0 + 4 * gg);
#pragma unroll
            for (int wv = 0; wv < 8; ++wv) s += red[(wv * 17 + r) * 32 + gg];
            *(f32x4*)(mods + ((size_t)(l * 17 + r) * MODN + n0 + 4 * gg)) = s; }
    }
    __syncthreads();
}

template <class RowMap>
__device__ __forceinline__ void conv_item(const float* W, int ldw, int K, bf16* WT, const RowMap& rm, float scale, LAS float* scr, int nblk, int item, int lane) {
    const int kb = item / nblk, nb = item % nblk, k0 = 64 * kb, n0 = 64 * nb, lr = lane >> 4, lg = lane & 15;
    f32x4 v[16];
#pragma unroll
    for (int i = 0; i < 16; ++i) v[i] = *(const f32x4*)(W + (size_t)(k0 + 4 * i + lr) * ldw + n0 + 4 * lg);
#pragma unroll
    for (int i = 0; i < 16; ++i) { LAS float* d = scr + (4 * i + lr) * 65 + 4 * lg; d[0] = v[i][0]; d[1] = v[i][1]; d[2] = v[i][2]; d[3] = v[i][3]; }
    LDS_WAIT(); asm volatile("" ::: "memory");
    const int c = lane & 7;
#pragma unroll
    for (int j = 0; j < 8; ++j) { const int n = (lane >> 3) + 8 * j; const LAS float* s = scr + (8 * c) * 65 + n;
        u32x4 o; o.x = cvtpk(s[0 * 65] * scale, s[1 * 65] * scale); o.y = cvtpk(s[2 * 65] * scale, s[3 * 65] * scale); o.z = cvtpk(s[4 * 65] * scale, s[5 * 65] * scale); o.w = cvtpk(s[6 * 65] * scale, s[7 * 65] * scale);
        *(u32x4*)(WT + (size_t)rm(n0 + n) * K + k0 + 8 * c) = o; }
    LDS_WAIT(); asm volatile("" ::: "memory");
}
struct RmId { __device__ __forceinline__ int operator()(int n) const { return n; } };
struct RmQKV {
    __device__ __forceinline__ int operator()(int n) const { if (n >= 2560) return n; const int dd = n & 127, base = n - dd, hh = dd >> 6, d2 = dd & 63; return base + hh * 64 + 2 * (d2 & 31) + (d2 >> 5); } };
struct RmGU { int up; __device__ __forceinline__ int operator()(int n) const { return 256 * (n >> 7) + 128 * up + (n & 127); } };

constexpr int CV_IG = (DM / 64) * (MOEH / 64), CV_ID = (MOEH / 64) * (DM / 64), CV_MOE_ITEMS = NEXP * (2 * CV_IG + CV_ID);
__device__ __forceinline__ void conv_moe_item(Frame& F, int l, int it, LAS float* scr) {
    bf16* WGU = (bf16*)(F.ws + WS_WGU); bf16* WD = (bf16*)(F.ws + WS_WD);
    const float* wg = F.in[I_MWG] + (size_t)l * NEXP * DM * MOEH; const float* wu = F.in[I_MWU] + (size_t)l * NEXP * DM * MOEH; const float* wd = F.in[I_MWD] + (size_t)l * NEXP * MOEH * DM;
    const int e = it / (2 * CV_IG + CV_ID); int r = it % (2 * CV_IG + CV_ID);
    if (r < CV_IG) { conv_item(wg + (size_t)e * DM * MOEH, MOEH, DM, WGU + (size_t)e * 1024 * DM, RmGU{0}, 1.f, scr, MOEH / 64, r, F.lane); return; } r -= CV_IG;
    if (r < CV_IG) { conv_item(wu + (size_t)e * DM * MOEH, MOEH, DM, WGU + (size_t)e * 1024 * DM, RmGU{1}, 1.f, scr, MOEH / 64, r, F.lane); return; } r -= CV_IG;
    conv_item(wd + (size_t)e * MOEH * DM, DM, MOEH, WD + (size_t)e * DM * MOEH, RmId{}, 1.f, scr, DM / 64, r, F.lane);
}
__device__ __forceinline__ void ph_conv_moe(Frame& F, int l) {
    LAS float* scr = (LAS float*)(F.lds + F.wave * 16640);
    const int gw = F.vcu * NWAVES + F.wave, NGW = F.G * NWAVES;
    for (int it = gw; it < CV_MOE_ITEMS; it += NGW) conv_moe_item(F, l, it, scr);
}
__device__ __forceinline__ void ph_conv0(Frame& F) {
    LAS float* scr = (LAS float*)(F.lds + F.wave * 16640);
    bf16* WQKV = (bf16*)(F.ws + WS_WQKV); bf16* WO = (bf16*)(F.ws + WS_WO); bf16* WIN = (bf16*)(F.ws + WS_WIN); bf16* WO2 = (bf16*)(F.ws + WS_WO2); bf16* WR = (bf16*)(F.ws + WS_WR);
    constexpr int I_Q = (DM / 64) * (NQKV / 64), I_O = (DM / 64) * (DM / 64), I_N = (DM / 64) * (6144 / 64), I_SMALL = I_Q + 2 * I_O + I_N, I_ALL = I_SMALL + CV_MOE_ITEMS;
    for (;;) {
        int base = 0; if (F.lane == 0) base = (int)atomicAdd(F.ctl + CW_WQ, 8u);
        base = __builtin_amdgcn_readfirstlane(base);
        if (base >= I_ALL) break;
        for (int it = base; it < base + 8 && it < I_ALL; ++it) {
            int r = it;
            if (r >= I_SMALL) { conv_moe_item(F, 0, r - I_SMALL, scr); continue; }
            if (r < I_Q) { conv_item(F.in[I_WQKV], NQKV, DM, WQKV, RmQKV{}, 1.f, scr, NQKV / 64, r, F.lane); continue; } r -= I_Q;
            if (r < I_O) { conv_item(F.in[I_WOA], DM, DM, WO, RmId{}, 1.f, scr, DM / 64, r, F.lane); continue; } r -= I_O;
            if (r < I_O) { conv_item(F.in[I_WOG], DM, DM, WO2, RmId{}, 1.f, scr, DM / 64, r, F.lane); continue; } r -= I_O;
            const int nb = r % (6144 / 64);
            conv_item(F.in[I_WIN], 6144, DM, WIN, RmId{}, nb < 16 ? 0.0625f : 1.f, scr, 6144 / 64, r, F.lane);
        }
    }
    const size_t gt = (size_t)(blockIdx.x) * NTHREADS + F.tid, gn = (size_t)F.G * NTHREADS;
    for (size_t i = gt; i < (size_t)224 * DM; i += gn) WIN[(size_t)(6176) * DM + i] = 0;
    for (size_t i = gt; i < (size_t)2 * DM * 16; i += gn) { const int d = (int)(i / (DM * 16)), k = (int)((i / 16) % DM), r = (int)(i % 16); WIN[(size_t)(6144 + 16 * d + r) * DM + k] = f2bf(F.in[I_GW1][i]); }
    for (size_t i = gt; i < (size_t)2 * 36 * DM; i += gn) { const int l = (int)(i / (36 * DM)), j = (int)((i / DM) % 36), k = (int)(i % DM);
        const float w = j < 4 ? F.in[I_MGW][((size_t)l * DM + k) * 4 + j] : F.in[I_MRW][((size_t)l * DM + k) * 32 + (j - 4)];
        const unsigned short hi = f2bf(w); const float lo = w - bf2f(hi);
        WR[((size_t)l * 256 + j) * DM + k] = hi; WR[((size_t)l * 256 + 36 + j) * DM + k] = f2bf(lo); }
    for (size_t i = gt; i < (size_t)2 * 184 * DM; i += gn) { const int l = (int)(i / (184 * DM)); const size_t o = i % ((size_t)184 * DM); WR[((size_t)l * 256 + 72) * DM + o] = 0; }
    float* cs = (float*)(F.ws + WS_ROPE);
    for (size_t i = gt; i < 64 * 32; i += gn) { const int pos = (int)(i >> 5), fi = (int)(i & 31); const float inv = powf(10000.f, -(float)(2 * fi) / 64.f); const float ang = (float)pos * inv;
        cs[2 * i] = cosf(ang); cs[2 * i + 1] = sinf(ang); }
}

__device__ __forceinline__ void row_load_f32(const float* p, int lane, float (&v)[32]) {
#pragma unroll
    for (int j = 0; j < 4; ++j) { const f32x4 a = *(const f32x4*)(p + 8 * lane + 512 * j), b = *(const f32x4*)(p + 8 * lane + 512 * j + 4);
        v[8 * j] = a[0]; v[8 * j + 1] = a[1]; v[8 * j + 2] = a[2]; v[8 * j + 3] = a[3]; v[8 * j + 4] = b[0]; v[8 * j + 5] = b[1]; v[8 * j + 6] = b[2]; v[8 * j + 7] = b[3]; }
}
__device__ __forceinline__ void row_load_bf16(const bf16* p, int lane, float (&v)[32]) {
#pragma unroll
    for (int j = 0; j < 4; ++j) { const u32x4 a = *(const u32x4*)(p + 8 * lane + 512 * j);
#pragma unroll
        for (int q = 0; q < 4; ++q) { v[8 * j + 2 * q] = bflo(a[q]); v[8 * j + 2 * q + 1] = bfhi(a[q]); } }
}
__device__ __forceinline__ void row_store_bf16(bf16* p, int lane, const float (&v)[32]) {
#pragma unroll
    for (int j = 0; j < 4; ++j) { u32x4 o; o.x = cvtpk(v[8 * j], v[8 * j + 1]); o.y = cvtpk(v[8 * j + 2], v[8 * j + 3]); o.z = cvtpk(v[8 * j + 4], v[8 * j + 5]); o.w = cvtpk(v[8 * j + 6], v[8 * j + 7]);
        *(u32x4*)(p + 8 * lane + 512 * j) = o; }
}
__device__ __forceinline__ void row_store_f32(float* p, int lane, const float (&v)[32]) {
#pragma unroll
    for (int j = 0; j < 4; ++j) { *(f32x4*)(p + 8 * lane + 512 * j) = (f32x4){v[8 * j], v[8 * j + 1], v[8 * j + 2], v[8 * j + 3]}; *(f32x4*)(p + 8 * lane + 512 * j + 4) = (f32x4){v[8 * j + 4], v[8 * j + 5], v[8 * j + 6], v[8 * j + 7]}; }
}
__device__ __forceinline__ void row_ln(float (&v)[32], const float* g, const float* b, int lane) {
    float s = 0.f;
#pragma unroll
    for (int i = 0; i < 32; ++i) s += v[i];
    const float mean = wave_sum(s) * (1.f / DM); float q = 0.f;
#pragma unroll
    for (int i = 0; i < 32; ++i) { v[i] -= mean; q += v[i] * v[i]; }
    const float rstd = 1.f / sqrtf(wave_sum(q) * (1.f / DM) + LN_EPS);
    float gv[32], bv[32]; row_load_f32(g, lane, gv); row_load_f32(b, lane, bv);
#pragma unroll
    for (int i = 0; i < 32; ++i) v[i] = v[i] * rstd * gv[i] + bv[i];
}
__device__ __forceinline__ void row_mod(float (&v)[32], const float* sh, const float* sc, int lane) {
    float a[32], b[32]; row_load_f32(sc, lane, a); row_load_f32(sh, lane, b);
#pragma unroll
    for (int i = 0; i < 32; ++i) v[i] = v[i] * (a[i] + 1.f) + b[i];
}
__device__ __forceinline__ void ph_mod0(Frame& F) {
    const int gw = F.vcu * NWAVES + F.wave, NGW = F.G * NWAVES; bf16* HB = (bf16*)(F.ws + WS_HB);
    for (int m = gw; m < MA; m += NGW) {
        const float* xr = m < ML ? F.in[I_X] + (size_t)m * DM : F.in[I_CTX] + (size_t)(m - ML) * DM; const int mr = mod_row(m);
        float v[32]; row_load_f32(xr, F.lane, v); row_mod(v, mods_ptr(F, 0, mr, 0), mods_ptr(F, 0, mr, 1), F.lane); row_store_bf16(HB + (size_t)m * DM, F.lane, v);
    }
}
__device__ __forceinline__ void ph_ln1(Frame& F, int l) {
    const int gw = F.vcu * NWAVES + F.wave, NGW = F.G * NWAVES; bf16* HB = (bf16*)(F.ws + WS_HB); bf16* VX = (bf16*)(F.ws + WS_VX);
    const int M = l ? ML : MA; const float* g = F.in[I_LNG] + (size_t)(l * 2 + 0) * DM; const float* b = F.in[I_LNB] + (size_t)(l * 2 + 0) * DM;
    for (int m = gw; m < M; m += NGW) { const int mr = mod_row(m);
        float v[32]; row_load_bf16(VX + (size_t)m * DM, F.lane, v); row_ln(v, g, b, F.lane);
        row_store_bf16(VX + (size_t)m * DM, F.lane, v);
        row_mod(v, mods_ptr(F, l, mr, 3), mods_ptr(F, l, mr, 4), F.lane); row_store_bf16(HB + (size_t)m * DM, F.lane, v); }
}
__device__ __forceinline__ void ph_ln2(Frame& F, int l) {
    const int gw = F.vcu * NWAVES + F.wave, NGW = F.G * NWAVES; bf16* HB = (bf16*)(F.ws + WS_HB); const bf16* VX = (const bf16*)(F.ws + WS_VX); const bf16* Y2 = (const bf16*)(F.ws + WS_Y2);
    const int M = l ? ML : MA; const float* g = F.in[I_LNG] + (size_t)(l * 2 + 1) * DM; const float* b = F.in[I_LNB] + (size_t)(l * 2 + 1) * DM;
    for (int m = gw; m < M; m += NGW) { const int mr = mod_row(m);
        float v[32], ya[32], yb[32], g2[32]; row_load_bf16(VX + (size_t)m * DM, F.lane, v); row_load_bf16(Y2 + (size_t)m * DM, F.lane, ya); row_load_bf16(Y2 + ((size_t)MA + m) * DM, F.lane, yb); row_load_f32(mods_ptr(F, l, mr, 5), F.lane, g2);
#pragma unroll
        for (int i = 0; i < 32; ++i) v[i] = v[i] * ALPHA + g2[i] * (ya[i] + yb[i]);
        row_ln(v, g, b, F.lane);
        if (l == 1) row_store_f32(F.out + (size_t)m * DM, F.lane, v);
        else { if (m < ML) row_store_bf16((bf16*)F.out + (size_t)m * DM, F.lane, v);
            row_mod(v, mods_ptr(F, 1, mr, 0), mods_ptr(F, 1, mr, 1), F.lane); row_store_bf16(HB + (size_t)m * DM, F.lane, v); } }
}


constexpr int SK_RS = 272, SK_A = 32 * SK_RS;
template <int NB>
__device__ __forceinline__ void skinny_gemm(Frame& F, const bf16* A, const bf16* W, float* out, int ldo, int M, int Gs = 0, int cs = 0) {
    const int lane = F.lane, r32 = lane & 31, hi = lane >> 5, tid = F.tid, w = F.wave;
    LAS unsigned char* Al = F.lds + w * SK_A; LAS unsigned char* Wl = F.lds + NWAVES * SK_A;
    const int Gd = Gs > 0 ? Gs : F.G, cd = Gs > 0 ? cs : F.vcu;
    const int nblk = M / 32, npass = (nblk + NWAVES * Gd - 1) / (NWAVES * Gd);
    for (int pass = 0; pass < npass; ++pass) {
        const int blk = pass * NWAVES * Gd + w * Gd + cd; const bool have = blk < nblk;
        f32x16 acc[NB];
#pragma unroll
        for (int nb = 0; nb < NB; ++nb)
#pragma unroll
            for (int r = 0; r < 16; ++r) acc[nb][r] = 0.f;
        const char* ag = (const char*)A + ((size_t)blk * 32 + (lane >> 4)) * (DM * 2) + (lane & 15) * 16;
        const int al = (lane >> 4) * SK_RS + (lane & 15) * 16;
        u32x4 ra[3][8], rw[3][NB];
#define SK_LOAD(sl_, q_) do { if (have) { _Pragma("unroll") for (int i_ = 0; i_ < 8; ++i_) ra[q_][i_] = *(const u32x4*)(ag + (size_t)i_ * 4 * (DM * 2) + (sl_) * 256); } \
            _Pragma("unroll") for (int i_ = 0; i_ < NB; ++i_) { const int idx_ = tid + 512 * i_; rw[q_][i_] = *(const u32x4*)((const char*)W + (size_t)(idx_ >> 4) * (DM * 2) + (sl_) * 256 + (idx_ & 15) * 16); } } while (0)
#define SK_BAR() do { asm volatile("s_waitcnt lgkmcnt(0)" ::: "memory"); __builtin_amdgcn_s_barrier(); asm volatile("" ::: "memory"); } while (0)
        SK_LOAD(0, 0); SK_LOAD(1, 1);
#pragma unroll
        for (int sl = 0; sl < DM / 128; ++sl) {
            SK_BAR();
            if (have) {
#pragma unroll
                for (int i = 0; i < 8; ++i) *(LAS u32x4*)(Al + al + i * 4 * SK_RS) = ra[sl % 3][i]; }
#pragma unroll
            for (int i = 0; i < NB; ++i) { const int idx = tid + 512 * i; *(LAS u32x4*)(Wl + (idx >> 4) * SK_RS + (idx & 15) * 16) = rw[sl % 3][i]; }
            SK_BAR();
            if (sl + 2 < DM / 128) SK_LOAD(sl + 2, (sl + 2) % 3);
            if (have) {
#pragma unroll
                for (int ks = 0; ks < 8; ++ks) {
                    const bf16x8 a = *(const LAS bf16x8*)(Al + r32 * SK_RS + (16 * ks + 8 * hi) * 2);
#pragma unroll
                    for (int nb = 0; nb < NB; ++nb) { const bf16x8 b = *(const LAS bf16x8*)(Wl + (32 * nb + r32) * SK_RS + (16 * ks + 8 * hi) * 2); acc[nb] = MFMA32(a, b, acc[nb]); }
                } }
        }
#undef SK_BAR
#undef SK_LOAD
        if (have) {
#pragma unroll
            for (int nb = 0; nb < NB; ++nb)
#pragma unroll
                for (int r = 0; r < 16; ++r) out[(size_t)(blk * 32 + crow(r, hi)) * ldo + 32 * nb + r32] = acc[nb][r]; }
    }
    __syncthreads();
}

__device__ __forceinline__ void ph_topk(Frame& F, int l) {
    const int M = l ? ML : MA; const float* LOG = (const float*)(F.ws + WS_LOG); unsigned* list = (unsigned*)(F.ws + WS_LIST); float* wlist = (float*)(F.ws + WS_WLIST);
    const float* gb = F.in[I_MGB] + l * 4; const float* rb = F.in[I_MRB] + l * 32; unsigned* cnt = F.ctl + CW_CNT + l * 32 * CW_STRIDE;
    const int nblk = M / 32, nslot = ((nblk + NWAVES * F.G - 1) / (NWAVES * F.G)) * NWAVES;
    for (int i = F.tid >> 5; i < nslot; i += NTHREADS / 32) {
        const int blk = (i >> 3) * NWAVES * F.G + (i & 7) * F.G + F.vcu; if (blk >= nblk) continue;
        const int m = blk * 32 + (F.tid & 31);
        const float* lg = LOG + (size_t)m * 256; float v[72];
#pragma unroll
        for (int j = 0; j < 18; ++j) { const f32x4 t = __builtin_nontemporal_load((const f32x4*)(lg + 4 * j)); v[4 * j] = t[0]; v[4 * j + 1] = t[1]; v[4 * j + 2] = t[2]; v[4 * j + 3] = t[3]; }
        float gl[4]; int gi = 0;
#pragma unroll
        for (int j = 0; j < 4; ++j) gl[j] = v[j] + v[36 + j] + gb[j];
        float gm = gl[0];
#pragma unroll
        for (int j = 1; j < 4; ++j) if (gl[j] > gm) { gm = gl[j]; gi = j; }
        float den = 0.f;
#pragma unroll
        for (int j = 0; j < 4; ++j) den += __expf(gl[j] - gm);
        const float gw = 1.f / den;
        float el[8];
#pragma unroll
        for (int j = 0; j < 8; ++j) { float a = 0.f;
#pragma unroll
            for (int q = 0; q < 4; ++q) { const float x = v[4 + q * 8 + j] + v[40 + q * 8 + j]; a = (q == gi) ? x : a; }
            el[j] = a + rb[gi * 8 + j]; }
        int i0 = 0; float v0 = el[0];
#pragma unroll
        for (int j = 1; j < 8; ++j) if (el[j] > v0) { v0 = el[j]; i0 = j; }
        int i1 = -1; float v1 = -3.0e38f;
#pragma unroll
        for (int j = 0; j < 8; ++j) if (j != i0 && el[j] > v1) { v1 = el[j]; i1 = j; }
        const float e1 = __expf(v1 - v0), w0 = gw / (1.f + e1), w1 = gw * e1 / (1.f + e1);
        const int ea = gi * 8 + i0, eb = gi * 8 + i1;
        const unsigned pa = atomicAdd(cnt + ea * CW_STRIDE, 1u), pb = atomicAdd(cnt + eb * CW_STRIDE, 1u);
        list[(size_t)ea * LISTCAP + pa] = 2u * m; wlist[(size_t)ea * LISTCAP + pa] = w0;
        list[(size_t)eb * LISTCAP + pb] = 2u * m + 1u; wlist[(size_t)eb * LISTCAP + pb] = w1;
    }
}
__device__ __forceinline__ MoeTables moe_tables(Frame& F, int l) {
    LAS int* toff = (LAS int*)(F.lds + MISC_OFF + 256); LAS int* cn = (LAS int*)(F.lds + MISC_OFF + 512);
    __syncthreads();
    if (F.tid < 32) {
        const int e = F.tid; const int n = (int)__hip_atomic_load(F.ctl + CW_CNT + (l * 32 + e) * CW_STRIDE, RLX_AGENT); const int tl = (n + 255) >> 8;
        int inc = tl;
#pragma unroll
        for (int d = 1; d < 32; d <<= 1) { const int t = __shfl_up(inc, d, 32); if (e >= d) inc += t; }
        cn[e] = n; toff[e] = inc - tl; if (e == 31) toff[32] = inc; }
    __syncthreads();
    MoeTables T; T.toff = toff; T.cnt = cn; return T;
}

__device__ __forceinline__ void ph_gates(Frame& F) {
    const float* GU = (const float*)(F.ws + WS_GU); float* BF = (float*)(F.ws + WS_VX); float* BB = BF + (size_t)MA * 1024;
    const float* gw2 = F.in[I_GW2]; const float* gbp = F.in[I_GB];
    LAS float* us = (LAS float*)F.lds;
    for (int ch = blockIdx.x; ch < MA / 32; ch += F.G) {
        __syncthreads();
        for (int i = F.tid; i < 1024; i += NTHREADS) us[i] = GU[(size_t)ch * 1024 + i];
        __syncthreads();
#pragma unroll 1
        for (int j = 0; j < 2; ++j) { const int c = F.tid + 512 * j;
#pragma unroll 1
            for (int d = 0; d < 2; ++d) {
                float w[16]; const float bias = gbp[d * 1024 + c];
#pragma unroll
                for (int r = 0; r < 16; ++r) w[r] = gw2[((size_t)d * 16 + r) * 1024 + c];
                float lgv[32];
#pragma unroll
                for (int t = 0; t < 32; ++t) { float p = bias; const LAS f32x4* up = (const LAS f32x4*)(us + t * 32 + d * 16);
#pragma unroll
                    for (int r4 = 0; r4 < 4; ++r4) { const f32x4 u4 = up[r4]; p += u4[0] * w[4 * r4] + u4[1] * w[4 * r4 + 1] + u4[2] * w[4 * r4 + 2] + u4[3] * w[4 * r4 + 3]; }
                    lgv[t] = (fminf(p, 0.f) - __logf(1.f + __expf(-fabsf(p)))) * 0.0625f; }
                float* dst = (d == 0 ? BF : BB) + (size_t)ch * 32 * 1024 + c;
                if (d == 0) { float a = 0.f;
#pragma unroll
                    for (int t = 0; t < 32; ++t) { a += lgv[t]; dst[(size_t)t * 1024] = a; } }
                else { float a = 0.f;
#pragma unroll
                    for (int t = 31; t >= 0; --t) { a += lgv[t]; dst[(size_t)t * 1024] = a; } }
            } }
    }
    __syncthreads();
}

__device__ __forceinline__ void ph_readout(Frame& F) {
    const int gw = F.vcu * NWAVES + F.wave, NGW = F.G * NWAVES;
    const bf16* OF = (const bf16*)(F.ws + WS_HB); const bf16* OB = (const bf16*)(F.ws + WS_OB); const bf16* GR = (const bf16*)(F.ws + WS_GR); bf16* A2 = (bf16*)(F.ws + WS_A2); const float* ng = F.in[I_NG];
    for (int m = gw; m < ML; m += NGW) {
        const size_t off = (size_t)m * DM + F.lane * 32;
        float o[32]; float ss = 0.f;
#pragma unroll
        for (int j = 0; j < 4; ++j) { const u32x4 a = *(const u32x4*)(OF + off + 8 * j), b = *(const u32x4*)(OB + off + 8 * j);
#pragma unroll
            for (int q = 0; q < 4; ++q) { const float lo = bflo(a[q]) + bflo(b[q]), hi = bfhi(a[q]) + bfhi(b[q]); o[8 * j + 2 * q] = lo; o[8 * j + 2 * q + 1] = hi; ss += lo * lo + hi * hi; } }
        ss += __shfl_xor(ss, 1); ss += __shfl_xor(ss, 2); ss += __shfl_xor(ss, 4); ss += __shfl_xor(ss, 8);
        const float rs = 1.f / sqrtf(ss * (1.f / GDV) + RMS_EPS);
        const int hc = (F.lane & 15) * 32;
#pragma unroll
        for (int j = 0; j < 4; ++j) { const u32x4 r = *(const u32x4*)(GR + off + 8 * j); const f32x4 g0 = *(const f32x4*)(ng + hc + 8 * j), g1 = *(const f32x4*)(ng + hc + 8 * j + 4);
            u32x4 w; w.x = cvtpk(o[8 * j] * rs * g0[0] * bflo(r.x), o[8 * j + 1] * rs * g0[1] * bfhi(r.x)); w.y = cvtpk(o[8 * j + 2] * rs * g0[2] * bflo(r.y), o[8 * j + 3] * rs * g0[3] * bfhi(r.y));
            w.z = cvtpk(o[8 * j + 4] * rs * g1[0] * bflo(r.z), o[8 * j + 5] * rs * g1[1] * bfhi(r.z)); w.w = cvtpk(o[8 * j + 6] * rs * g1[2] * bflo(r.w), o[8 * j + 7] * rs * g1[3] * bfhi(r.w));
            *(u32x4*)(A2 + off + 8 * j) = w; }
    }
}
constexpr int ATT_KS = 272, ATT_VS = 320, ATT_KB = 64 * ATT_KS, ATT_VB = 64 * ATT_VS, ATT_STAGE = ATT_KB + ATT_VB;
__device__ __forceinline__ void attn_tile_of(int t, int ntw, int nb_lo, int qb, int b, int& krow0, int& mtype, int& th) {
    if (t < ntw) { const int nb = nb_lo + (t >> 1); th = t & 1; krow0 = b * SEQ + nb * 128 + 64 * th; mtype = nb < qb ? 1 : (nb > qb ? 2 : 0); }
    else { krow0 = ML + b * CTXL + 64 * (t - ntw); mtype = 0; th = 0; }
}
__device__ __forceinline__ void ph_attn(Frame& F) {
    const bf16* Q = (const bf16*)(F.ws + WS_Q); const bf16* Kg = (const bf16*)(F.ws + WS_K); const bf16* Vg = (const bf16*)(F.ws + WS_V); bf16* O = (bf16*)(F.ws + WS_O);
    const float* sink = F.in[I_SINK];
    const int lane = F.lane, w = F.wave, r32 = lane & 31, hi = lane >> 5, tid = F.tid;
    LAS unsigned char* lds = F.lds;
    const int vtr_base = (4 * hi + ((lane & 15) >> 2)) * ATT_VS + (16 * ((lane >> 4) & 1) + 4 * (lane & 3)) * 2;
#define ATT_UNIT(uid_, b_, kvh_, hp_, qb_, nb_lo_, ntw_) do { const int v2_ = (uid_) & 255, s_ = (uid_) >> 8, combo_ = v2_ >> 1, half_ = v2_ & 1; \
        b_ = combo_ >> 3; kvh_ = (combo_ >> 1) & 3; hp_ = combo_ & 1; qb_ = s_ < 8 ? half_ * 8 + s_ : 16 + half_; nb_lo_ = 0; ntw_ = 0; \
        if (qb_ < 16) { nb_lo_ = qb_ > 0 ? qb_ - 1 : 0; const int nb_hi_ = qb_ < 15 ? qb_ + 1 : 15; ntw_ = 2 * (nb_hi_ - nb_lo_ + 1); } } while (0)
#define ATT_QROW(b_, qb_) ((qb_) < 16 ? (b_) * SEQ + (qb_) * 128 + qr0 + r32 : ML + (b_) * CTXL + ((qb_) - 16) * 128 + qr0 + r32)
    const int qr0 = 32 * (w & 3), srow0 = tid >> 4, sc = tid & 15;
    bf16x8 qn[8]; u32x4 stk[2], stv[2]; bool pref = false;
    for (int uid = F.vcu; uid < 2304; uid += F.G) {
        int b, kvh, hp, qb, nb_lo, ntw; ATT_UNIT(uid, b, kvh, hp, qb, nb_lo, ntw);
        const int head = 4 * kvh + 2 * hp + (w >> 2);
        const int qrow = ATT_QROW(b, qb);
        const int NT = ntw + 4;
        bf16x8 qf[8];
        int krow0, mtype, th;
        attn_tile_of(0, ntw, nb_lo, qb, b, krow0, mtype, th);
        if (!pref) {
#pragma unroll
            for (int ks = 0; ks < 8; ++ks) qf[ks] = *(const bf16x8*)(Q + (size_t)qrow * DM + head * 128 + 16 * ks + 8 * hi);
#pragma unroll
            for (int i = 0; i < 2; ++i) { const size_t g = (size_t)(krow0 + srow0 + 32 * i) * 512 + kvh * 128 + 8 * sc; stk[i] = *(const u32x4*)(Kg + g); stv[i] = *(const u32x4*)(Vg + g); }
        } else {
#pragma unroll
            for (int ks = 0; ks < 8; ++ks) qf[ks] = qn[ks];
        }
        float m_run = sink[head] * LOG2E, l_run = 1.f;
        f32x16 ot[4];
#pragma unroll
        for (int d = 0; d < 4; ++d)
#pragma unroll
            for (int r = 0; r < 16; ++r) ot[d][r] = 0.f;
        __syncthreads();
#pragma unroll
        for (int i = 0; i < 2; ++i) { *(LAS u32x4*)(lds + (srow0 + 32 * i) * ATT_KS + 16 * sc) = stk[i]; *(LAS u32x4*)(lds + ATT_KB + (srow0 + 32 * i) * ATT_VS + 16 * sc) = stv[i]; }
        __syncthreads();
        for (int t = 0; t < NT; ++t) {
            LAS unsigned char* kb = lds + (t & 1) * ATT_STAGE; LAS unsigned char* vb = kb + ATT_KB;
            int krow1, mtype1, th1;
            if (t + 1 < NT) { attn_tile_of(t + 1, ntw, nb_lo, qb, b, krow1, mtype1, th1);
#pragma unroll
                for (int i = 0; i < 2; ++i) { const size_t g = (size_t)(krow1 + srow0 + 32 * i) * 512 + kvh * 128 + 8 * sc; stk[i] = *(const u32x4*)(Kg + g); stv[i] = *(const u32x4*)(Vg + g); } }
            else { pref = uid + F.G < 2304;
                if (pref) { int b2, kvh2, hp2, qb2, nbl2, ntw2; ATT_UNIT(uid + F.G, b2, kvh2, hp2, qb2, nbl2, ntw2); int kr2, mt2, th2; attn_tile_of(0, ntw2, nbl2, qb2, b2, kr2, mt2, th2);
                    const int head2 = 4 * kvh2 + 2 * hp2 + (w >> 2), qrow2 = ATT_QROW(b2, qb2);
#pragma unroll
                    for (int ks = 0; ks < 8; ++ks) qn[ks] = *(const bf16x8*)(Q + (size_t)qrow2 * DM + head2 * 128 + 16 * ks + 8 * hi);
#pragma unroll
                    for (int i = 0; i < 2; ++i) { const size_t g = (size_t)(kr2 + srow0 + 32 * i) * 512 + kvh2 * 128 + 8 * sc; stk[i] = *(const u32x4*)(Kg + g); stv[i] = *(const u32x4*)(Vg + g); } } }
            const bool act = !((mtype == 1 && th == 0 && (w & 3) >= 2) || (mtype == 2 && th == 1 && (w & 3) <= 1));
            if (act) {
            f32x16 p0, p1;
#pragma unroll
            for (int r = 0; r < 16; ++r) { p0[r] = 0.f; p1[r] = 0.f; }
#pragma unroll
            for (int ks = 0; ks < 8; ++ks) {
                const bf16x8 a0 = *(const LAS bf16x8*)(kb + r32 * ATT_KS + (16 * ks + 8 * hi) * 2);
                const bf16x8 a1 = *(const LAS bf16x8*)(kb + (32 + r32) * ATT_KS + (16 * ks + 8 * hi) * 2);
                p0 = MFMA32(a0, qf[ks], p0); p1 = MFMA32(a1, qf[ks], p1);
            }
            if (mtype == 1) { asm volatile("" ::: "memory");
                const int d = qr0 + r32 - 64 * th - 4 * hi; const float NEG = -__builtin_inff();
#pragma unroll
                for (int r = 0; r < 16; ++r) { const int c = (r & 3) + 8 * (r >> 2); p0[r] = (c >= d) ? p0[r] : NEG; p1[r] = (c + 32 >= d) ? p1[r] : NEG; }
            } else if (mtype == 2) { asm volatile("" ::: "memory");
                const int d = qr0 + r32 - 64 * th - 4 * hi; const float NEG = -__builtin_inff();
#pragma unroll
                for (int r = 0; r < 16; ++r) { const int c = (r & 3) + 8 * (r >> 2); p0[r] = (c <= d) ? p0[r] : NEG; p1[r] = (c + 32 <= d) ? p1[r] : NEG; }
            }
            float mx = p0[0];
#pragma unroll
            for (int r = 1; r < 16; ++r) mx = fmaxf(mx, p0[r]);
#pragma unroll
            for (int r = 0; r < 16; ++r) mx = fmaxf(mx, p1[r]);
            mx = fmaxf(mx, __shfl_xor(mx, 32));
            const float mn = fmaxf(m_run, mx), alpha = fexp2(m_run - mn); m_run = mn;
            float ps = 0.f;
#pragma unroll
            for (int r = 0; r < 16; ++r) { p0[r] = fexp2(p0[r] - mn); p1[r] = fexp2(p1[r] - mn); ps += p0[r] + p1[r]; }
            ps += __shfl_xor(ps, 32);
            l_run = l_run * alpha + ps;
            if (__any(alpha != 1.f)) {
#pragma unroll
            for (int d = 0; d < 4; ++d)
#pragma unroll
                for (int r = 0; r < 16; ++r) ot[d][r] *= alpha; }
#pragma unroll
            for (int s4 = 0; s4 < 4; ++s4) {
                u32x4 pw;
                if (s4 == 0) { pw.x = cvtpk(p0[0], p0[1]); pw.y = cvtpk(p0[2], p0[3]); pw.z = cvtpk(p0[4], p0[5]); pw.w = cvtpk(p0[6], p0[7]); }
                if (s4 == 1) { pw.x = cvtpk(p0[8], p0[9]); pw.y = cvtpk(p0[10], p0[11]); pw.z = cvtpk(p0[12], p0[13]); pw.w = cvtpk(p0[14], p0[15]); }
                if (s4 == 2) { pw.x = cvtpk(p1[0], p1[1]); pw.y = cvtpk(p1[2], p1[3]); pw.z = cvtpk(p1[4], p1[5]); pw.w = cvtpk(p1[6], p1[7]); }
                if (s4 == 3) { pw.x = cvtpk(p1[8], p1[9]); pw.y = cvtpk(p1[10], p1[11]); pw.z = cvtpk(p1[12], p1[13]); pw.w = cvtpk(p1[14], p1[15]); }
                const bf16x8 pf = __builtin_bit_cast(bf16x8, pw);
#pragma unroll
                for (int d = 0; d < 4; ++d) {
                    const s16x4 lo = tr_read(vb + vtr_base + 16 * s4 * ATT_VS + 64 * d), hi4 = tr_read(vb + vtr_base + (16 * s4 + 8) * ATT_VS + 64 * d);
                    ot[d] = MFMA32(cat8(lo, hi4), pf, ot[d]);
                }
            }
            }
            if (t + 1 < NT) {
                LAS unsigned char* kn = lds + ((t + 1) & 1) * ATT_STAGE;
#pragma unroll
                for (int i = 0; i < 2; ++i) { *(LAS u32x4*)(kn + (srow0 + 32 * i) * ATT_KS + 16 * sc) = stk[i]; *(LAS u32x4*)(kn + ATT_KB + (srow0 + 32 * i) * ATT_VS + 16 * sc) = stv[i]; }
                krow0 = krow1; mtype = mtype1; th = th1;
            }
            __syncthreads();
        }
        const float inv = 1.f / l_run;
        bf16* orow = O + (size_t)qrow * DM + head * 128 + 4 * hi;
#pragma unroll
        for (int d = 0; d < 4; ++d)
#pragma unroll
            for (int g = 0; g < 4; ++g) { u32x2 o; o.x = cvtpk(ot[d][4 * g] * inv, ot[d][4 * g + 1] * inv); o.y = cvtpk(ot[d][4 * g + 2] * inv, ot[d][4 * g + 3] * inv);
                *(u32x2*)(orow + 32 * d + 8 * g) = o; }
    }
    __syncthreads();
#undef ATT_UNIT
#undef ATT_QROW
}
constexpr size_t WS_QD = WS_VX, WS_KD = WS_VX + 128 * MiB, WS_DD = WS_VX + 272 * MiB;
constexpr int GP_TS = 80;
__device__ __forceinline__ void ph_gprep(Frame& F) {
    const bf16* GQ = (const bf16*)(F.ws + WS_GQ); const bf16* GK = (const bf16*)(F.ws + WS_GK); const float* GU = (const float*)(F.ws + WS_GU);
    bf16* QD = (bf16*)(F.ws + WS_QD); bf16* KD = (bf16*)(F.ws + WS_KD); float* DD = (float*)(F.ws + WS_DD);
    const float* gw2 = F.in[I_GW2]; const float* gbp = F.in[I_GB];
    const int lane = F.lane, r32 = lane & 31, hi = lane >> 5;
    LAS unsigned char* KT = F.lds + F.wave * (4 * 32 * GP_TS); LAS unsigned char* QT = KT + 2 * 32 * GP_TS;
    const int gw = F.vcu * NWAVES + F.wave, NGW = F.G * NWAVES;
    for (int combo = gw & 31, part = gw >> 5, nparts = NGW >> 5; part < nparts && nparts > 0; part = nparts) {
        const int dir = combo >> 4, c0 = 64 * (combo & 15), tl = dir ? 0 : 31;
        u32x4 ph[2], pl[2]; float bias[2];
#pragma unroll
        for (int c = 0; c < 2; ++c) { float wv[8]; bias[c] = gbp[dir * 1024 + c0 + 32 * c + r32];
#pragma unroll
            for (int j = 0; j < 8; ++j) wv[j] = gw2[((size_t)dir * 16 + 8 * hi + j) * 1024 + c0 + 32 * c + r32];
#pragma unroll
            for (int j = 0; j < 4; ++j) { const unsigned hw = cvtpk(wv[2 * j], wv[2 * j + 1]); ph[c][j] = hw; pl[c][j] = cvtpk(wv[2 * j] - bflo(hw), wv[2 * j + 1] - bfhi(hw)); } }
        u32x4 lf0, lf1;
#pragma unroll
        for (int j = 0; j < 4; ++j) {
            const int sa = 8 * ((2 * j) >> 2) + 4 * hi + ((2 * j) & 3), sb2 = sa + 1;
            const bool a0 = dir ? (sa >= r32) : (sa <= r32), a1 = dir ? (sb2 >= r32) : (sb2 <= r32), c0b = dir ? (sa + 16 >= r32) : (sa + 16 <= r32), c1 = dir ? (sb2 + 16 >= r32) : (sb2 + 16 <= r32);
            lf0[j] = (a0 ? 0u : 0xBF80u) | (a1 ? 0u : 0xBF800000u); lf1[j] = (c0b ? 0u : 0xBF80u) | (c1 ? 0u : 0xBF800000u); }
        const u32x4 onesf = {0x3F803F80u, 0x3F803F80u, 0x3F803F80u, 0x3F803F80u};
        const int srow = lane >> 3, spc = lane & 7;
        const unsigned goff = (unsigned)(srow * 2048 + c0 * 2 + spc * 16);
        const int toff = (spc >> 2) * (32 * GP_TS) + srow * GP_TS + (spc & 3) * 16;
        u32x4 nk[4], nq[4]; f32x4 nu0, nu1;
        constexpr int NCH = MA / 32;
#define GP_LOAD(ch_) do { const size_t rb_ = (size_t)(ch_) * 32; const char* kp_ = (const char*)GK + rb_ * 2048; _Pragma("unroll") for (int i_ = 0; i_ < 4; ++i_) nk[i_] = *(const u32x4*)(kp_ + goff + i_ * 8 * 2048); \
            if (rb_ < (size_t)ML) { const char* qp_ = (const char*)GQ + rb_ * 2048; _Pragma("unroll") for (int i_ = 0; i_ < 4; ++i_) nq[i_] = *(const u32x4*)(qp_ + goff + i_ * 8 * 2048); } \
            const float* up_ = GU + (rb_ + r32) * 32 + 16 * dir + 8 * hi; nu0 = *(const f32x4*)up_; nu1 = *(const f32x4*)(up_ + 4); } while (0)
        int ch = part;
        if (ch < NCH) GP_LOAD(ch);
#pragma unroll 1
        for (; ch < NCH; ch += nparts) {
            const int row0 = 32 * ch; const bool isctx = row0 >= ML;
#pragma unroll
            for (int i = 0; i < 4; ++i) *(LAS u32x4*)(KT + toff + i * 8 * GP_TS) = nk[i];
            if (!isctx) {
#pragma unroll
                for (int i = 0; i < 4; ++i) *(LAS u32x4*)(QT + toff + i * 8 * GP_TS) = nq[i]; }
            u32x4 uh, ul;
            { const float uu[8] = {nu0[0], nu0[1], nu0[2], nu0[3], nu1[0], nu1[1], nu1[2], nu1[3]};
#pragma unroll
              for (int j = 0; j < 4; ++j) { const unsigned hw = cvtpk(uu[2 * j], uu[2 * j + 1]); uh[j] = hw; ul[j] = cvtpk(uu[2 * j] - bflo(hw), uu[2 * j + 1] - bfhi(hw)); } }
            if (ch + nparts < NCH) GP_LOAD(ch + nparts);
            f32x16 pre[2], bb[2], bl[2];
#pragma unroll
            for (int c = 0; c < 2; ++c) {
#pragma unroll
                for (int r = 0; r < 16; ++r) pre[c][r] = 0.f;
                pre[c] = MFMA32(__builtin_bit_cast(bf16x8, uh), __builtin_bit_cast(bf16x8, ph[c]), pre[c]); pre[c] = MFMA32(__builtin_bit_cast(bf16x8, ul), __builtin_bit_cast(bf16x8, ph[c]), pre[c]);
                pre[c] = MFMA32(__builtin_bit_cast(bf16x8, uh), __builtin_bit_cast(bf16x8, pl[c]), pre[c]); }
#pragma unroll
            for (int c = 0; c < 2; ++c)
#pragma unroll
                for (int r = 0; r < 16; ++r) { const float p = pre[c][r] + bias[c];
                    pre[c][r] = (fminf(p, 0.f) - __builtin_amdgcn_logf(1.f + fexp2(-fabsf(p) * LOG2E)) * 0.6931471805599453f) * 0.0625f; }
#pragma unroll
            for (int c = 0; c < 2; ++c) {
#pragma unroll
                for (int r = 0; r < 16; ++r) { bb[c][r] = 0.f; bl[c][r] = 0.f; }
#pragma unroll
                for (int st = 0; st < 2; ++st) { u32x4 lh, ll;
#pragma unroll
                    for (int j = 0; j < 4; ++j) { const float a = pre[c][8 * st + 2 * j], cc = pre[c][8 * st + 2 * j + 1]; const unsigned hw = cvtpk(a, cc); lh[j] = hw; ll[j] = cvtpk(a - bflo(hw), cc - bfhi(hw)); }
                    const bf16x8 lf = __builtin_bit_cast(bf16x8, st ? lf1 : lf0);
                    bb[c] = MFMA32(__builtin_bit_cast(bf16x8, lh), lf, bb[c]); bb[c] = MFMA32(__builtin_bit_cast(bf16x8, ll), lf, bb[c]);
                    bl[c] = MFMA32(__builtin_bit_cast(bf16x8, lh), __builtin_bit_cast(bf16x8, onesf), bl[c]); bl[c] = MFMA32(__builtin_bit_cast(bf16x8, ll), __builtin_bit_cast(bf16x8, onesf), bl[c]); } }
            asm volatile("s_waitcnt lgkmcnt(0)" ::: "memory");
            const int pb = r32 * GP_TS + 8 * hi;
#pragma unroll
            for (int g = 0; g < 4; ++g)
#pragma unroll
              for (int c = 0; c < 2; ++c) { float e[4];
#pragma unroll
                for (int j = 0; j < 4; ++j) e[j] = bb[c][4 * g + j] * LOG2E;
                LAS u32x2* kp = (LAS u32x2*)(KT + c * (32 * GP_TS) + pb + 16 * g); const u32x2 kw = *kp; u32x2 ko;
                ko.x = cvtpk(bflo(kw.x) * fexp2(-e[0]), bfhi(kw.x) * fexp2(-e[1])); ko.y = cvtpk(bflo(kw.y) * fexp2(-e[2]), bfhi(kw.y) * fexp2(-e[3])); *kp = ko;
                if (!isctx) { LAS u32x2* qp = (LAS u32x2*)(QT + c * (32 * GP_TS) + pb + 16 * g); const u32x2 qw = *qp; u32x2 qo;
                    qo.x = cvtpk(bflo(qw.x) * fexp2(e[0]), bfhi(qw.x) * fexp2(e[1])); qo.y = cvtpk(bflo(qw.y) * fexp2(e[2]), bfhi(qw.y) * fexp2(e[3])); *qp = qo; } }
            if (r32 == tl) {
#pragma unroll
                for (int c = 0; c < 2; ++c)
#pragma unroll
                    for (int g = 0; g < 4; ++g) { f32x4 d;
#pragma unroll
                        for (int j = 0; j < 4; ++j) d[j] = fexp2(bl[c][4 * g + j] * LOG2E);
                        *(f32x4*)(DD + ((size_t)ch * 2 + dir) * 1024 + c0 + 32 * c + 8 * g + 4 * hi) = d; } }
            asm volatile("s_waitcnt lgkmcnt(0)" ::: "memory");
            { char* kq = (char*)KD + ((size_t)dir * MA + row0) * 2048;
#pragma unroll
              for (int i = 0; i < 4; ++i) *(u32x4*)(kq + goff + i * 8 * 2048) = *(const LAS u32x4*)(KT + toff + i * 8 * GP_TS); }
            if (!isctx) { char* qq = (char*)QD + ((size_t)dir * ML + row0) * 2048;
#pragma unroll
              for (int i = 0; i < 4; ++i) *(u32x4*)(qq + goff + i * 8 * 2048) = *(const LAS u32x4*)(QT + toff + i * 8 * GP_TS); }
            asm volatile("s_waitcnt lgkmcnt(0)" ::: "memory");
        }
#undef GP_LOAD
    }
    __syncthreads();
}

constexpr int SC_QS = 528, SC_KS = 576, SC_VS = 576, SC_AS = 80;
constexpr int SC_QI = 0, SC_KI = SC_QI + 32 * SC_QS, SC_VI = SC_KI + 32 * SC_KS, SC_DI = SC_VI + 32 * SC_VS, SC_BUF = SC_DI + 1024;
constexpr int SC_ATT = 2 * SC_BUF, SC_END = SC_ATT + 32 * SC_AS;
static_assert(SC_END <= MISC_OFF, "scan LDS");
struct ScanRaw { u32x4 q0, q1, k0, k1, v0, v1; f32x4 d; };
__device__ __forceinline__ void scan_chunk_pos(int ci, int dir, int b, bool& isctx, int& row0) {
    isctx = ci < 8; const int cc = isctx ? ci : ci - 8, nch = isctx ? 8 : 64, c = dir ? nch - 1 - cc : cc;
    row0 = isctx ? ML + b * CTXL + 32 * c : b * SEQ + 32 * c;
}
#define SC_BARRIER() do { asm volatile("s_waitcnt lgkmcnt(0)" ::: "memory"); __builtin_amdgcn_s_barrier(); asm volatile("" ::: "memory"); } while (0)
#define SC_ADDR(name, base, off) int name = (base) + (off); asm volatile("" : "+v"(name))
template <int ABL>
__device__ __forceinline__ void ph_scan_t(Frame& F) {
    const bf16* QD = (const bf16*)(F.ws + WS_QD); const bf16* KD = (const bf16*)(F.ws + WS_KD); const bf16* GV = (const bf16*)(F.ws + WS_GV); const float* DD = (const float*)(F.ws + WS_DD);
    bf16* OF = (bf16*)(F.ws + ((ABL & 256) ? WS_GQ : WS_HB)); bf16* OB = (bf16*)(F.ws + ((ABL & 256) ? WS_GQ : WS_OB));
    LAS unsigned char* lds = F.lds;
    const int w = F.wave;
    for (int uid = F.vcu; uid < 256; uid += F.G) {
    const int tid = F.wave * 64 + lane_id_v();
    const int lane = tid & 63, r32 = lane & 31, hi = lane >> 5, i16 = lane & 15, g16 = (lane >> 4) & 1;
    const int trq = i16 >> 2, trp = i16 & 3, pt = tid >> 4, cg = tid & 15;
    const int kwb = SC_KI + pt * SC_KS + cg * 32, qwb = SC_QI + pt * SC_QS + cg * 32, vwb = SC_VI + pt * SC_VS + cg * 32, dwb = SC_DI + lane * 16;
    const int kab = SC_KI + (16 * ((w >> 1) & 1) + i16) * SC_KS + 16 * (lane >> 4), qab = SC_QI + (16 * (w & 1) + i16) * SC_QS + 16 * (lane >> 4);
    const int atw = SC_ATT + (16 * (w & 1) + i16) * SC_AS + (16 * ((w >> 1) & 1) + 4 * (lane >> 4)) * 2;
    const int drb = SC_DI + 16 * hi, qrb = SC_QI + r32 * SC_QS + 8 * hi, vtb = SC_VI + (8 * hi + trq) * SC_VS + (32 * w + 16 * g16 + 4 * trp) * 2, ktb = SC_KI + (8 * hi + trq) * SC_KS + (16 * g16 + 4 * trp) * 2;
    const int arb = SC_ATT + r32 * SC_AS + 16 * hi;
        const int b = uid >> 4, h = (uid >> 2) & 3, dir = (uid >> 1) & 1, sl = uid & 1;
        bf16* Od = dir ? OB : OF;
        const bf16* Qd = QD + (size_t)dir * ML * 1024; const bf16* Kd = KD + (size_t)dir * MA * 1024;
        unsigned amask = 0u;
        { const int s0 = 16 * ((w >> 1) & 1) + 4 * (lane >> 4), tt = 16 * (w & 1) + i16;
#pragma unroll
          for (int j = 0; j < 4; ++j) amask |= ((dir ? (s0 + j >= tt) : (s0 + j <= tt)) ? 1u : 0u) << j; }
        asm volatile("" : "+v"(amask));
        f32x16 S[8];
#pragma unroll
        for (int k = 0; k < 8; ++k)
#pragma unroll
            for (int r = 0; r < 16; ++r) S[k][r] = 0.f;
        if constexpr (ABL != 0) {
#pragma unroll
            for (int k = 0; k < 8; ++k) asm volatile("" : "+v"(S[k]));
        }
        ScanRaw R;
        const unsigned koff = (unsigned)(pt * 2048 + (h * 256 + 16 * cg) * 2), voff = (unsigned)(pt * 4096 + (h * 512 + sl * 256 + 16 * cg) * 2), doff = (unsigned)((h * 256 + 4 * lane) * 4);
        const unsigned ooff = (unsigned)(r32 * 4096 + (h * 512 + sl * 256 + 32 * w + 4 * hi) * 2);
#define SCAN_LOAD(cj) do { bool ic_; int r0_; scan_chunk_pos((cj), dir, b, ic_, r0_); \
            const char* kb_ = (const char*)Kd + (size_t)r0_ * 2048; R.k0 = *(const u32x4*)(kb_ + koff); R.k1 = *(const u32x4*)(kb_ + koff + 16); \
            if (!ic_) { const char* qb_ = (const char*)Qd + (size_t)r0_ * 2048; R.q0 = *(const u32x4*)(qb_ + koff); R.q1 = *(const u32x4*)(qb_ + koff + 16); } \
            const char* vb_ = (const char*)GV + (size_t)r0_ * 4096; R.v0 = *(const u32x4*)(vb_ + voff); R.v1 = *(const u32x4*)(vb_ + voff + 16); \
            if (w == 0) R.d = *(const f32x4*)((const char*)DD + ((size_t)(r0_ >> 5) * 2 + dir) * 4096 + doff); } while (0)
#define SCAN_WRITE(cj) do { bool ic_; int r0_; scan_chunk_pos((cj), dir, b, ic_, r0_); (void)r0_; const int ibo_ = ((cj) & 1) * SC_BUF; \
            SC_ADDR(ka_, kwb, ibo_); *(LAS u32x4*)(lds + ka_) = R.k0; *(LAS u32x4*)(lds + ka_ + 16) = R.k1; \
            if (!ic_) { SC_ADDR(qa_, qwb, ibo_); *(LAS u32x4*)(lds + qa_) = R.q0; *(LAS u32x4*)(lds + qa_ + 16) = R.q1; } \
            SC_ADDR(va_, vwb, ibo_); *(LAS u32x4*)(lds + va_) = R.v0; *(LAS u32x4*)(lds + va_ + 16) = R.v1; \
            if (w == 0) { SC_ADDR(da_, dwb, ibo_); *(LAS f32x4*)(lds + da_) = R.d; } } while (0)

        __syncthreads();
        SCAN_LOAD(0); SCAN_WRITE(0); SCAN_LOAD(1);
        __syncthreads();
#pragma unroll 1
        for (int ci = 0; ci < 72; ++ci) {
            bool isctx; int row0; scan_chunk_pos(ci, dir, b, isctx, row0);
            const int ibo = (ci & 1) * SC_BUF;
            if (!(ABL & 32)) { if (ci + 1 < 72) { SCAN_WRITE(ci + 1); } }
            if (!(ABL & 16)) { if (ci + 2 < 72) { SCAN_LOAD(ci + 2); } }
            if (!(ABL & 8) && !isctx && w < 4) {
                f32x4 a4 = {0.f, 0.f, 0.f, 0.f}; SC_ADDR(ka, kab, ibo); SC_ADDR(qa, qab, ibo);
#pragma unroll
                for (int k8 = 0; k8 < 8; ++k8) { const bf16x8 kf = *(const LAS bf16x8*)(lds + ka + 64 * k8); const bf16x8 qf = *(const LAS bf16x8*)(lds + qa + 64 * k8); a4 = MFMA16(kf, qf, a4); }
#pragma unroll
                for (int j = 0; j < 4; ++j) a4[j] = ((amask >> j) & 1u) ? a4[j] : 0.f;
                u32x2 o; o.x = cvtpk(a4[0], a4[1]); o.y = cvtpk(a4[2], a4[3]);
                *(LAS u32x2*)(lds + atw) = o;
            }
            if constexpr (!(ABL & 1)) { SC_ADDR(da, drb, ibo);
#pragma unroll
              for (int k = 0; k < 8; ++k)
#pragma unroll
                for (int g = 0; g < 4; ++g) { const f32x4 d4 = *(const LAS f32x4*)(lds + da + (32 * k + 8 * g) * 4);
#pragma unroll
                    for (int j = 0; j < 4; ++j) S[k][4 * g + j] *= d4[j]; } }
            f32x16 ot;
#pragma unroll
            for (int r = 0; r < 16; ++r) ot[r] = 0.f;
            if (!(ABL & 2) && !isctx) {
                SC_ADDR(qa, qrb, ibo);
#pragma unroll
                for (int k = 0; k < 8; ++k)
#pragma unroll
                    for (int s2 = 0; s2 < 2; ++s2) {
                        u32x4 sw; sw.x = cvtpk(S[k][8 * s2], S[k][8 * s2 + 1]); sw.y = cvtpk(S[k][8 * s2 + 2], S[k][8 * s2 + 3]); sw.z = cvtpk(S[k][8 * s2 + 4], S[k][8 * s2 + 5]); sw.w = cvtpk(S[k][8 * s2 + 6], S[k][8 * s2 + 7]);
                        const u32x2 qx = *(const LAS u32x2*)(lds + qa + (32 * k + 16 * s2) * 2), qc = *(const LAS u32x2*)(lds + qa + (32 * k + 16 * s2) * 2 + 16);
                        u32x4 qw; qw.x = qx.x; qw.y = qx.y; qw.z = qc.x; qw.w = qc.y;
                        ot = MFMA32(__builtin_bit_cast(bf16x8, sw), __builtin_bit_cast(bf16x8, qw), ot);
                    }
            }
            if constexpr (!(ABL & 128)) SC_BARRIER();
            bf16x8 vf[2];
            { SC_ADDR(va, vtb, ibo);
#pragma unroll
              for (int ts = 0; ts < 2; ++ts) vf[ts] = cat8(tr_read(lds + va + 16 * ts * SC_VS), tr_read(lds + va + (16 * ts + 4) * SC_VS)); }
            if (!(ABL & 64) && !isctx) {
#pragma unroll
                for (int ts = 0; ts < 2; ++ts) { const bf16x8 af = *(const LAS bf16x8*)(lds + arb + 32 * ts); ot = MFMA32(vf[ts], af, ot); }
                char* op = (char*)Od + (size_t)row0 * 4096;
#pragma unroll
                for (int g = 0; g < 4; ++g) { u32x2 o; o.x = cvtpk(ot[4 * g], ot[4 * g + 1]); o.y = cvtpk(ot[4 * g + 2], ot[4 * g + 3]); *(u32x2*)(op + ooff + 16 * g) = o; }
            }
            if ((ABL & 64) && !(ABL & 2) && !isctx) { asm volatile("" :: "v"(ot)); }
            if constexpr (!(ABL & 4)) { SC_ADDR(ka, ktb, ibo);
#pragma unroll
              for (int k = 0; k < 8; ++k)
#pragma unroll
                for (int ts = 0; ts < 2; ++ts) S[k] = MFMA32(cat8(tr_read(lds + ka + 16 * ts * SC_KS + 64 * k), tr_read(lds + ka + (16 * ts + 4) * SC_KS + 64 * k)), vf[ts], S[k]); }
            if constexpr (!(ABL & 128)) SC_BARRIER();
        }
        if constexpr (ABL != 0) {
#pragma unroll
            for (int k = 0; k < 8; ++k) asm volatile("" :: "v"(S[k]));
        }
#undef SCAN_LOAD
#undef SCAN_WRITE
    }
    __syncthreads();
}
__device__ __forceinline__ void ph_scan(Frame& F) {
    ph_scan_t<0>(F);
#ifdef SCAN_ABL
#ifndef SCAN_ABL_REP
#define SCAN_ABL_REP 1
#endif
#pragma unroll 1
    for (int rep = 0; rep < SCAN_ABL_REP; ++rep) ph_scan_t<SCAN_ABL>(F);
#endif
}
constexpr int N_PHASES = 22;
#define TAIL_PHASES(l, pb) \
    if (IN(pb)) REP(pb) { PH_BEGIN(); \
        ProbDense P; P.K = DM; P.A = (const bf16*)(ws + (l ? WS_A2 : WS_O)); P.Bt = (const bf16*)(ws + (l ? WS_WO2 : WS_WO)); P.S.init((l ? ML : MA) / 256, DM / 256, F.G, (int)blockIdx.x); \
        EpiWOut E{(bf16*)(ws + WS_VX), l ? (const float*)nullptr : F.in[I_X], F.in[I_CTX], (const bf16*)F.out, (const float*)(ws + WS_MODS) + (size_t)l * 17 * MODN}; \
        pg8::gemm_phase<EpiWOut, ProbDense, true>(F.lds, P, E, F.wave); \
    } SEAM(pb); \
    if (IN(pb + 1)) REP(pb + 1) { PH_BEGIN(); ph_ln1(F, l); } SEAM(pb + 1); \
    if (IN(pb + 2)) REP(pb + 2) { PH_BEGIN(); skinny_gemm<3>(F, (const bf16*)(ws + WS_HB), (const bf16*)(ws + WS_WR) + (size_t)l * 256 * DM, (float*)(ws + WS_LOG), 256, l ? ML : MA); \
        PH_BEGIN(); ph_topk(F, l); } SEAM(pb + 2);     \
    if (IN(pb + 4)) REP(pb + 4) { PH_BEGIN(); \
        const MoeTables Tb = moe_tables(F, l); \
        ProbGU P; P.K = DM; P.A = (const bf16*)(ws + WS_HB); P.Bt = (const bf16*)(ws + WS_WGU); P.list = (const unsigned*)(ws + WS_LIST); P.Tb = Tb; P.G = F.G; P.c = (int)blockIdx.x; \
        EpiGU E{(bf16*)(ws + WS_HID)}; \
        pg8::gemm_phase<EpiGU, ProbGU, true>(F.lds, P, E, F.wave); \
    } SEAM(pb + 4); \
    if (IN(pb + 5)) REP(pb + 5) { PH_BEGIN(); \
        const MoeTables Tb = moe_tables(F, l); \
        ProbDown P; P.K = MOEH; P.A = (const bf16*)(ws + WS_HID); P.Bt = (const bf16*)(ws + WS_WD); P.Tb = Tb; P.G = F.G; P.c = (int)blockIdx.x; \
        EpiDown E{(bf16*)(ws + WS_Y2), (const unsigned*)(ws + WS_LIST), (const float*)(ws + WS_WLIST)}; \
        pg8::gemm_phase<EpiDown, ProbDown, true>(F.lds, P, E, F.wave); \
    } SEAM(pb + 5); \
    if (IN(pb + 6)) REP(pb + 6) { PH_BEGIN(); ph_ln2(F, l); if (l == 0) ph_conv_moe(F, 1); } SEAM(pb + 6);

#define KARGS_DECL const float* i0, const float* i1, const float* i2, const float* i3, const float* i4, const float* i5, const float* i6, const float* i7, const float* i8, const float* i9, const float* i10, const float* i11, \
    const float* i12, const float* i13, const float* i14, const float* i15, const float* i16, const float* i17, const float* i18, const float* i19, const float* i20, const float* i21, const float* i22, const float* i23, \
    float* outp, unsigned char* wsp, int ph_lo, int ph_hi
__global__ void __launch_bounds__(NTHREADS, 2) fwd_kernel(KARGS_DECL) {
    const float* const inarr[24] = {i0, i1, i2, i3, i4, i5, i6, i7, i8, i9, i10, i11, i12, i13, i14, i15, i16, i17, i18, i19, i20, i21, i22, i23};
    extern __shared__ __attribute__((aligned(16))) unsigned char lds_raw[];
    Frame F;
    F.lds = (LAS unsigned char*)lds_raw;
    F.tid = threadIdx.x; F.lane = F.tid & 63; F.wave = __builtin_amdgcn_readfirstlane(F.tid >> 6);
    F.G = gridDim.x; { const int bx = blockIdx.x; F.vcu = (F.G % 8 == 0) ? (bx % 8) * (F.G / 8) + bx / 8 : bx; }
    F.in.p = inarr; F.out = outp; F.ws = wsp; F.ctl = (unsigned*)(F.ws + WS_CTL);
    for (int u = F.tid; u < (LDS_BYTES - MISC_OFF) / 4; u += NTHREADS) ((LAS unsigned*)(F.lds + MISC_OFF))[u] = 0u;
    __syncthreads();
    const int lo = ph_lo, hi = ph_hi;
    XcdBarrier bar; bar.bar = F.ctl + CW_BAR; bar.x = 0; bar.st = nullptr;
    if (hi - lo > 1) bar = xcd_barrier_post(F.ctl + CW_BAR, (volatile LAS unsigned*)(F.lds + MISC_OFF + 32), F.tid);
#ifdef ONLY_SET
#define IN(k) (((ONLY_SET >> (k)) & 1) && lo <= (k) && (k) < hi)
#else
#define IN(k) (lo <= (k) && (k) < hi)
#endif
#ifndef DUP_MASK
#define DUP_MASK 0
#endif
#ifndef DUP_REPS
#define DUP_REPS 2
#endif
#define REP(k) for (int rep_ = 0; rep_ < ((((DUP_MASK) >> (k)) & 1) ? DUP_REPS : 1); ++rep_)
#define PH_BEGIN() do { F.tid = F.wave * 64 + lane_id(); asm volatile("" : "+v"(F.tid)); F.lane = F.tid & 63; } while (0)
#ifdef EXTRA_BAR
#define SEAM(k) do { if (IN(k) && IN((k) + 1)) { xcd_barrier(bar, F.wave * 64 + lane_id()); if ((k) & 1) { xcd_barrier(bar, F.wave * 64 + lane_id()); xcd_barrier(bar, F.wave * 64 + lane_id()); } } } while (0)
#else
#define SEAM(k) do { if (IN(k) && IN((k) + 1)) xcd_barrier(bar, F.wave * 64 + lane_id()); } while (0)
#endif
    unsigned char* ws = F.ws;
    if (IN(0)) REP(0) { PH_BEGIN(); ph_mods(F); ph_conv0(F); } SEAM(0);
    if (IN(1)) REP(1) { PH_BEGIN(); ph_mod0(F); } SEAM(1);
    if (IN(2)) REP(2) { PH_BEGIN();
        ProbDense P; P.K = DM; P.A = (const bf16*)(ws + WS_HB); P.Bt = (const bf16*)(ws + WS_WQKV); P.S.init(MA / 256, NQKV / 256, F.G, (int)blockIdx.x);
        EpiQKV E{(bf16*)(ws + WS_Q), (bf16*)(ws + WS_K), (bf16*)(ws + WS_V), (const float*)(ws + WS_ROPE)};
        pg8::gemm_phase<EpiQKV, ProbDense, true>(F.lds, P, E, F.wave);
    } SEAM(2);
    if (IN(3)) REP(3) { PH_BEGIN(); ph_attn(F); } SEAM(3);
    TAIL_PHASES(0, 4)
    if (IN(11)) REP(11) { PH_BEGIN();
        ProbProj P; P.K = DM; P.A = (const bf16*)(ws + WS_HB); P.Bt = (const bf16*)(ws + WS_WIN); P.S.init(ML / 256, 24, F.G, (int)blockIdx.x); P.G = F.G; P.c = (int)blockIdx.x;
        EpiProj E{(bf16*)(ws + WS_GQ), (bf16*)(ws + WS_GK), (bf16*)(ws + WS_GV), (bf16*)(ws + WS_GR), (float*)(ws + WS_GU)};
        pg8::gemm_phase<EpiProj, ProbProj, true>(F.lds, P, E, F.wave);
        { const int nun = (ML / 256) * 24 + 16 * 12, c0 = nun - ((nun + F.G - 1) / F.G - 1) * F.G, c = (int)blockIdx.x;
          PH_BEGIN();
          if (c0 >= F.G) skinny_gemm<1>(F, (const bf16*)(ws + WS_HB), (const bf16*)(ws + WS_WIN) + (size_t)6144 * DM, (float*)(ws + WS_GU), 32, MA);
          else if (c >= c0) skinny_gemm<1>(F, (const bf16*)(ws + WS_HB), (const bf16*)(ws + WS_WIN) + (size_t)6144 * DM, (float*)(ws + WS_GU), 32, MA, F.G - c0, c - c0); }
    } SEAM(11);
    if (IN(12)) REP(12) { PH_BEGIN(); ph_gprep(F); } SEAM(12);
    if (IN(13)) REP(13) { PH_BEGIN(); ph_scan(F); } SEAM(13);
    if (IN(14)) REP(14) { PH_BEGIN(); ph_readout(F); } SEAM(14);
    TAIL_PHASES(1, 15)
#undef IN
#undef SEAM
}

extern "C" void kernel_launch(void* const* d_in, const int* in_sizes, int n_in, void* d_out, int out_size, void* d_ws, size_t ws_size, hipStream_t stream) {
    static int grid = 0;
    if (grid == 0) {
        if (n_in != 24 || out_size != ML * DM || ws_size < WS_END) { fprintf(stderr, "kernel_launch: unexpected problem (n_in %d out %d ws %zu need %zu)\n", n_in, out_size, ws_size, (size_t)WS_END); grid = -1; return; }
        int dev = 0, cus = 0, per_cu = 0;
        if (hipGetDevice(&dev) != hipSuccess || hipDeviceGetAttribute(&cus, hipDeviceAttributeMultiprocessorCount, dev) != hipSuccess) { grid = -1; return; }
        if (hipFuncSetAttribute((const void*)fwd_kernel, hipFuncAttributeMaxDynamicSharedMemorySize, LDS_BYTES) != hipSuccess) { fprintf(stderr, "kernel_launch: hipFuncSetAttribute failed\n"); grid = -1; return; }
        if (hipOccupancyMaxActiveBlocksPerMultiprocessor(&per_cu, (const void*)fwd_kernel, NTHREADS, LDS_BYTES) != hipSuccess || per_cu < 1) { fprintf(stderr, "kernel_launch: occupancy query says %d\n", per_cu); }
        (void)hipGetLastError();
        grid = cus;
    }
    if (grid < 0) return;
    (void)hipMemsetAsync((char*)d_ws + WS_CTL, 0, CTL_ZERO_BYTES, stream);
    const float* in[24];
    for (int i = 0; i < 24; ++i) in[i] = (const float*)d_in[i];
#define KARGS(lo_, hi_) in[0], in[1], in[2], in[3], in[4], in[5], in[6], in[7], in[8], in[9], in[10], in[11], in[12], in[13], in[14], in[15], in[16], in[17], in[18], in[19], in[20], in[21], in[22], in[23], (float*)d_out, (unsigned char*)d_ws, (lo_), (hi_)
#if MK_FUSED
    hipLaunchKernelGGL(fwd_kernel, dim3(grid), dim3(NTHREADS), LDS_BYTES, stream, KARGS(0, N_PHASES));
#else
    for (int p = 0; p < N_PHASES; ++p) hipLaunchKernelGGL(fwd_kernel, dim3(grid), dim3(NTHREADS), LDS_BYTES, stream, KARGS(p, p + 1));
#endif
}
```

```cpp
#include <hip/hip_runtime.h>
#include <cstdio>
#include <cstdint>

#ifndef MK_FUSED
#define MK_FUSED 1
#endif
#ifndef MK_CHECK
#define MK_CHECK 0
#endif

#define GAS __attribute__((address_space(1)))
#define LAS __attribute__((address_space(3)))
typedef unsigned short bf16;
typedef short bf16x8 __attribute__((ext_vector_type(8)));
typedef short s16x4 __attribute__((ext_vector_type(4)));
typedef float f32x2 __attribute__((ext_vector_type(2)));
typedef float f32x4 __attribute__((ext_vector_type(4)));
typedef float f32x16 __attribute__((ext_vector_type(16)));
typedef unsigned u32x2 __attribute__((ext_vector_type(2)));
typedef unsigned u32x4 __attribute__((ext_vector_type(4)));
typedef __bf16 bf16x2_t __attribute__((ext_vector_type(2)));
typedef short v4i16_t __attribute__((ext_vector_type(4)));

constexpr int DM = 2048, NBATCH = 16, SEQ = 2048, CTXL = 256;
constexpr int ML = NBATCH * SEQ, MC = NBATCH * CTXL, MA = ML + MC;
constexpr int NQKV = 3072, NPROJ = 6400, MODN = 6 * DM, NEXP = 32, MOEH = 512;
constexpr int HD = 128, NHEAD = 16, NKV = 4;
constexpr int GLAH = 4, GDK = 256, GDV = 512;
constexpr float ALPHA = 1.41421356237309515f;
constexpr float LN_EPS = 1e-5f, RMS_EPS = 1e-6f;
constexpr float LOG2E = 1.4426950408889634f;
constexpr float QSCALE = 0.08838834764831845f * LOG2E;

constexpr size_t MiB = 1u << 20;
constexpr size_t WS_CTL = 0, CTL_ZERO_BYTES = 16 * 1024;
constexpr size_t WS_MODS = 1 * MiB;
constexpr size_t WS_ROPE = 3 * MiB;
constexpr size_t WS_WQKV = 4 * MiB, WS_WO = 16 * MiB, WS_WIN = 24 * MiB, WS_WO2 = 50 * MiB, WS_WR = 58 * MiB;
constexpr size_t WS_WGU = 60 * MiB, WS_WD = 188 * MiB;
constexpr size_t WS_VX = 252 * MiB;
constexpr size_t WS_HB = 540 * MiB;
constexpr size_t WS_R1 = 684 * MiB;
constexpr size_t WS_Q = WS_R1, WS_K = WS_R1 + 144 * MiB, WS_V = WS_R1 + 180 * MiB, WS_O = WS_R1 + 216 * MiB;
constexpr size_t WS_GQ = WS_R1, WS_GK = WS_R1 + 64 * MiB, WS_A2 = WS_R1, WS_GV = WS_R1 + 136 * MiB, WS_GR = WS_R1 + 280 * MiB, WS_GU = WS_R1 + 408 * MiB, WS_OB = WS_R1 + 413 * MiB;
constexpr size_t WS_LOG = WS_R1, WS_LIST = WS_R1 + 36 * MiB, WS_WLIST = WS_R1 + 45 * MiB, WS_HID = WS_R1 + 56 * MiB, WS_Y2 = WS_R1 + 136 * MiB;
constexpr size_t WS_END = WS_R1 + 541 * MiB;
constexpr int LISTCAP = 2 * MA;
constexpr int CW_TMO = 0, CW_CODE = 1;
constexpr int CW_BAR = 32;
constexpr int CW_STRIDE = 32;
constexpr int CW_CNT = 1664;
constexpr int CW_WQ = 1664 + 64 * 32;
static_assert((CW_WQ + 32) * 4 <= (int)CTL_ZERO_BYTES, "control words");

constexpr int RING_BYTES = 131072;
constexpr int MISC_OFF = 139264;
constexpr int LDS_BYTES = 147456;
constexpr int NWAVES = 8, NTHREADS = 512;

#define RLX_AGENT __ATOMIC_RELAXED, __HIP_MEMORY_SCOPE_AGENT
#define LDS_WAIT() asm volatile("s_waitcnt lgkmcnt(0)" ::: "memory")
#define VM_WAIT() asm volatile("s_waitcnt vmcnt(0)" ::: "memory")

__device__ __forceinline__ unsigned cvtpk(float lo, float hi) { f32x2 v = {lo, hi}; bf16x2_t b = __builtin_convertvector(v, bf16x2_t); return __builtin_bit_cast(unsigned, b); }
__device__ __forceinline__ float bf2f(unsigned short b) { return __uint_as_float(((unsigned)b) << 16); }
__device__ __forceinline__ float bflo(unsigned w) { return __uint_as_float(w << 16); }
__device__ __forceinline__ float bfhi(unsigned w) { return __uint_as_float(w & 0xffff0000u); }
__device__ __forceinline__ unsigned short f2bf(float f) { return (unsigned short)(cvtpk(f, 0.f) & 0xffffu); }
__device__ __forceinline__ float fexp2(float x) { return __builtin_amdgcn_exp2f(x); }
__device__ __forceinline__ float frcp(float x) { return __builtin_amdgcn_rcpf(x); }
__device__ __forceinline__ float silu_f(float x) { return x * frcp(1.f + fexp2(-x * LOG2E)); }
__device__ __forceinline__ float wave_sum(float v) {
#pragma unroll
    for (int o = 1; o < 64; o <<= 1) v += __shfl_xor(v, o);
    return v;
}
__device__ __forceinline__ int lane_id() { return (int)__builtin_amdgcn_mbcnt_hi(~0u, __builtin_amdgcn_mbcnt_lo(~0u, 0u)); }
__device__ __forceinline__ int lane_id_v() { int l; asm volatile("v_mbcnt_lo_u32_b32 %0, -1, 0\n\tv_mbcnt_hi_u32_b32 %0, -1, %0" : "=v"(l)); return l; }
__device__ __forceinline__ int crow(int r, int hi) { return (r & 3) + 8 * (r >> 2) + 4 * hi; }
__device__ __forceinline__ s16x4 tr_read(const LAS void* p) { return __builtin_bit_cast(s16x4, __builtin_amdgcn_ds_read_tr16_b64_v4i16((LAS v4i16_t*)p)); }
__device__ __forceinline__ bf16x8 cat8(s16x4 a, s16x4 b) { return __builtin_shufflevector(a, b, 0, 1, 2, 3, 4, 5, 6, 7); }
#define MFMA32(a, b, c) __builtin_amdgcn_mfma_f32_32x32x16_bf16((a), (b), (c), 0, 0, 0)
#define MFMA16(a, b, c) __builtin_amdgcn_mfma_f32_16x16x32_bf16((a), (b), (c), 0, 0, 0)

#define XB_TMO      0
#define XB_XCNT(j)  (32   + 32 * (j))
#define XB_XSUB(j)  (544  + 32 * (j))
#define XB_XGEN(j)  (1056 + 32 * (j))
#define XB_TOP      1568
#define XB_TOPGEN   1600
#define XCD_BAR_WORDS 1632
#define XB_SPIN_CAP (1u << 18)
__device__ __forceinline__ unsigned xb_ld(unsigned* p)              { return __hip_atomic_load(p, __ATOMIC_RELAXED, __HIP_MEMORY_SCOPE_AGENT); }
__device__ __forceinline__ unsigned xb_add(unsigned* p, unsigned v) { return __hip_atomic_fetch_add(p, v, __ATOMIC_RELAXED, __HIP_MEMORY_SCOPE_AGENT); }
__device__ __forceinline__ unsigned xb_xcc_id() { return (unsigned)__builtin_amdgcn_s_getreg((3 << 11) | 20) & 0xFu; }
#define XB_SPIN(cond, bar) do { unsigned _sp = 0; while (cond) { __builtin_amdgcn_s_sleep(1); \
    if ((++_sp & 255u) == 0u) { if (xb_ld(&(bar)[XB_TMO])) break; if (_sp > XB_SPIN_CAP) { atomicAdd(&(bar)[XB_TMO], 1u); break; } } } } while (0)
struct XcdBarrier { unsigned* bar; unsigned x; volatile LAS unsigned* st; };
__device__ __forceinline__ XcdBarrier xcd_barrier_post(unsigned* bar, volatile LAS unsigned* st, int tid) {
    XcdBarrier b; b.bar = bar; b.x = xb_xcc_id(); b.st = st;
    if (tid == 0) (void)xb_add(&bar[XB_XCNT(b.x)], 1u);
    return b;
}
__device__ __forceinline__ void xcd_barrier_complete(unsigned* bar, unsigned x, unsigned& nloc, unsigned& nx) {
    const unsigned G = gridDim.x * gridDim.y * gridDim.z;
    unsigned sum, cnt, mine, sp = 0u;
    for (;;) {
        sum = 0u; cnt = 0u; mine = 0u;
#pragma unroll
        for (unsigned j = 0; j < 16; ++j) { const unsigned c = xb_ld(&bar[XB_XCNT(j)]); sum += c; cnt += (c > 0u) ? 1u : 0u; mine = (j == x) ? c : mine; }
        if (sum == G) break;
        __builtin_amdgcn_s_sleep(1);
        if ((++sp & 255u) == 0u) { if (xb_ld(&bar[XB_TMO])) break; if (sp > XB_SPIN_CAP) { atomicAdd(&bar[XB_TMO], 1u); break; } }
    }
    nloc = mine > 0u ? mine : 1u; nx = cnt > 0u ? cnt : 1u;
}
__device__ __forceinline__ void xcd_barrier(const XcdBarrier& b, int tid) {
    asm volatile("s_waitcnt vmcnt(0)" ::: "memory");
    __syncthreads();
    if (tid == 0) {
        unsigned* bar = b.bar;
        __builtin_amdgcn_s_waitcnt(0);
        unsigned nloc = b.st[0], nx = b.st[1];
        if (nloc == 0u) { xcd_barrier_complete(bar, b.x, nloc, nx); b.st[0] = nloc; b.st[1] = nx; }
        const unsigned old = xb_add(&bar[XB_XSUB(b.x)], 1u);
        const unsigned gen = old / nloc;
        if (old + 1u == (gen + 1u) * nloc) {
            __builtin_amdgcn_fence(__ATOMIC_RELEASE, "agent");
            asm volatile("s_waitcnt vmcnt(0)" ::: "memory");
            const unsigned og = xb_add(&bar[XB_TOP], 1u);
            const unsigned tg = og / nx;
            __builtin_amdgcn_fence(__ATOMIC_ACQUIRE, "agent");
            if (og + 1u == (tg + 1u) * nx) xb_add(&bar[XB_TOPGEN], 1u);
            else XB_SPIN(xb_ld(&bar[XB_TOPGEN]) == tg, bar);
            asm volatile("s_waitcnt vmcnt(0)" ::: "memory");
        } else {
            __builtin_amdgcn_fence(__ATOMIC_ACQUIRE, "agent");
            XB_SPIN(xb_ld(&bar[XB_TOPGEN]) == gen, bar);
            asm volatile("s_waitcnt vmcnt(0)" ::: "memory");
        }
    }
    __syncthreads();
}

struct Args { const float* in[24]; float* out; unsigned char* ws; int ph_lo, ph_hi, li, pad; };
enum { I_X = 0, I_C, I_CTX, I_CCTX, I_MODW, I_MODB, I_LNG, I_LNB, I_WQKV, I_WOA, I_SINK, I_WIN, I_GW1, I_GW2, I_GB, I_NG, I_WOG, I_MGW, I_MGB, I_MRW, I_MRB, I_MWG, I_MWU, I_MWD };
struct InPtrs { const float* const* p; __device__ __forceinline__ const float* operator[](int i) const { return p[i]; } };
struct Frame {
    LAS unsigned char* lds;
    unsigned* ctl;
    int tid, lane, wave, vcu, G;
    InPtrs in; float* out; unsigned char* ws;
};
__device__ __forceinline__ const float* mods_ptr(const Frame& F, int l, int mr, int chunk) { return (const float*)(F.ws + WS_MODS) + ((size_t)(l * 17 + mr) * MODN + chunk * DM); }
__device__ __forceinline__ int mod_row(int m) { return m < ML ? (m >> 11) : 16; }
namespace pg8 {
constexpr int BM = 256, BK = 64, HALF = 128, HTB = HALF * BK * 2, STAGE_BYTES = 8 * HTB, NXCD = 8, WGM = 8;
__host__ __device__ __forceinline__ int lds_byte(int r, int c) { const int st = (r >> 4) * 2 + (c >> 5), rr = r & 15, cc = c & 31, ob = rr * 64 + cc * 2; return st * 1024 + (ob ^ (((ob >> 9) & 1) << 5)); }
__host__ __device__ __forceinline__ void stage_rc(int b, int& R, int& C) { const int st = b / 1024, sb = b % 1024, swz = sb ^ (((sb >> 9) & 1) << 5); R = (st >> 1) * 16 + swz / 64; C = (st & 1) * 32 + (swz % 64) / 2; }
__host__ __device__ __forceinline__ int perm32(int rho) { const int n = rho >> 4, i = rho & 15; return 8 * (i >> 2) + 4 * n + (i & 3); }

struct Unit { int pm, pn, e, lrow0, valid; };

struct StaticOrder {
    int nM, nN, nwg, G, c;
    __device__ void init(int nM_, int nN_, int G_, int c_) { nM = nM_; nN = nN_; nwg = nM * nN; G = G_; c = c_; }
    __device__ bool map(int i, int& pm, int& pn) const {
        const long L = (long)i * G + c; if (L >= nwg) return false;
        int wgid = (int)L; { const int q = nwg / NXCD, r = nwg % NXCD, xcd = wgid % NXCD, off = wgid / NXCD; wgid = (xcd < r ? xcd * (q + 1) : r * (q + 1) + (xcd - r) * q) + off; }
        const int nig = WGM * nN, gid = wgid / nig, fm = gid * WGM, gsz = (nM - fm) < WGM ? (nM - fm) : WGM;
        pm = fm + ((wgid % nig) % gsz); pn = (wgid % nig) / gsz; return true;
    }
};

template <class Epi, class Prob, bool ALIGN_EPI>
__device__ __forceinline__ void gemm_phase(LAS unsigned char* lds, const Prob& P, const Epi& E, int wave) {
    const int wid = wave, lane = lane_id(), tid = wid * 64 + lane, wr = wid >> 2, wc = wid & 3, fr = lane & 15, fq = lane >> 4;
    const int K = P.K, nt = K / BK;
    unsigned voffB[2][2];
#pragma unroll
    for (int i = 0; i < 2; ++i) { int R, C; stage_rc(tid * 16 + i * 8192, R, C); const int Rb = Epi::PERM ? ((R & ~31) + perm32(R & 31)) : R;
        voffB[0][i] = (unsigned)(Rb * K + C) * 2u; voffB[1][i] = (unsigned)((Rb + HALF) * K + C) * 2u; }
    const size_t kstep = (size_t)(BK * 2);
    const unsigned ldsw = (unsigned)wid * 1024u;
    const int aoff = lds_byte(wr * 64 + fr, fq * 8), boff = lds_byte(wc * 32 + fr, fq * 8);
#define PG8_SA(b, h) (((b) * 2 + (h)) * HTB)
#define PG8_SB(b, h) ((4 + (b) * 2 + (h)) * HTB)
#define PG8_STAGE(bufoff, gbase, v0, v1) do { \
        __builtin_amdgcn_global_load_lds((const unsigned*)((const char*)(gbase) + (v0)), (LAS unsigned*)(lds + (bufoff) + ldsw), 16, 0, 0); \
        __builtin_amdgcn_global_load_lds((const unsigned*)((const char*)(gbase) + (v1)), (LAS unsigned*)(lds + (bufoff) + ldsw + 8192), 16, 0, 0); } while (0)
#define PG8_LDA(dst, b, h) do { _Pragma("unroll") for (int m = 0; m < 4; ++m) _Pragma("unroll") for (int k = 0; k < 2; ++k) dst[m][k] = *(const LAS bf16x8*)(lds + PG8_SA(b, h) + aoff + m * 2048 + k * 1024); } while (0)
#define PG8_LDB(dst, b, h) do { _Pragma("unroll") for (int n = 0; n < 2; ++n) _Pragma("unroll") for (int k = 0; k < 2; ++k) dst[n][k] = *(const LAS bf16x8*)(lds + PG8_SB(b, h) + boff + n * 2048 + k * 1024); } while (0)
#define PG8_MMA(ai, bj, At, Bt) do { __builtin_amdgcn_s_setprio(1); _Pragma("unroll") for (int m = 0; m < 4; ++m) _Pragma("unroll") for (int n = 0; n < 2; ++n) _Pragma("unroll") for (int k = 0; k < 2; ++k) \
        acc[ai][bj][m][n] = __builtin_amdgcn_mfma_f32_16x16x32_bf16(Bt[n][k], At[m][k], acc[ai][bj][m][n], 0, 0, 0); __builtin_amdgcn_s_setprio(0); } while (0)
#define PG8_WAIT_V(n) asm volatile("s_waitcnt vmcnt(" #n ")" ::: "memory")
#define PG8_WAIT_L(n) asm volatile("s_waitcnt lgkmcnt(" #n ")" ::: "memory")
#define PG8_BAR __builtin_amdgcn_s_barrier()
#define PG8_SCHED __builtin_amdgcn_sched_barrier(0)
    Unit cur, nxt; int ui = 0;
    if (!P.next(0, cur)) return;
    f32x4 acc[2][2][4][2];
#pragma unroll
    for (int a = 0; a < 2; ++a)
#pragma unroll
        for (int b = 0; b < 2; ++b)
#pragma unroll
            for (int m = 0; m < 4; ++m)
#pragma unroll
                for (int n = 0; n < 2; ++n) acc[a][b][m][n] = (f32x4){0.f, 0.f, 0.f, 0.f};
    bf16x8 At[4][2], B0[2][2], B1[2][2];
    const char* cA; const char* nA; unsigned cva[2][2], nva[2][2];
    P.a_setup(cur, cA, cva, tid);
    const char* cB = P.b_base(cur); const char* nB;
    PG8_STAGE(PG8_SB(0, 0), cB, voffB[0][0], voffB[0][1]); PG8_STAGE(PG8_SB(0, 1), cB, voffB[1][0], voffB[1][1]); PG8_STAGE(PG8_SA(0, 0), cA, cva[0][0], cva[0][1]); PG8_STAGE(PG8_SA(0, 1), cA, cva[1][0], cva[1][1]);
    if (wr == 1) PG8_BAR;
    PG8_WAIT_V(2); PG8_BAR;
    PG8_STAGE(PG8_SB(1, 0), cB + kstep, voffB[0][0], voffB[0][1]); PG8_STAGE(PG8_SA(1, 0), cA + kstep, cva[0][0], cva[0][1]); PG8_STAGE(PG8_SB(1, 1), cB + kstep, voffB[1][0], voffB[1][1]);
    PG8_WAIT_V(6); PG8_BAR;
    for (;;) {
        const bool has_next = P.next(ui + 1, nxt);
        nA = cA; nB = cB;
        if constexpr (Prob::GATHER) {
#pragma unroll
        for (int h = 0; h < 2; ++h)
#pragma unroll
            for (int i = 0; i < 2; ++i) nva[h][i] = cva[h][i]; }
        for (int t = 0; t < nt; t += 2) {
            const bool last = (t == nt - 2);
            if (last && has_next) { if constexpr (Prob::GATHER) P.a_setup(nxt, nA, nva, tid); else nA = P.a_base(nxt); nB = P.b_base(nxt); }
            const char* a1 = cA + (size_t)(t + 1) * kstep;
            const char* a2 = last ? nA : cA + (size_t)(t + 2) * kstep; const char* b2 = last ? nB : cB + (size_t)(t + 2) * kstep;
            const char* a3 = a2 + kstep; const char* b3 = b2 + kstep;
            unsigned x00 = cva[0][0], x01 = cva[0][1], x10 = cva[1][0], x11 = cva[1][1];
            if constexpr (Prob::GATHER) { x00 = last ? nva[0][0] : x00; x01 = last ? nva[0][1] : x01; x10 = last ? nva[1][0] : x10; x11 = last ? nva[1][1] : x11; }
            PG8_LDB(B0, 0, 0); PG8_LDB(B1, 0, 1); PG8_SCHED; PG8_LDA(At, 0, 0); PG8_STAGE(PG8_SA(1, 1), a1, cva[1][0], cva[1][1]);
            PG8_WAIT_V(8); PG8_WAIT_L(0); PG8_BAR; PG8_MMA(0, 0, At, B0); PG8_MMA(0, 1, At, B1); PG8_BAR; PG8_SCHED;
            PG8_LDA(At, 0, 1); PG8_STAGE(PG8_SB(0, 0), b2, voffB[0][0], voffB[0][1]); PG8_STAGE(PG8_SB(0, 1), b2, voffB[1][0], voffB[1][1]); PG8_STAGE(PG8_SA(0, 0), a2, x00, x01);
            PG8_WAIT_V(8); PG8_WAIT_L(0); PG8_BAR; PG8_MMA(1, 0, At, B0); PG8_MMA(1, 1, At, B1); PG8_BAR; PG8_SCHED;
            PG8_LDB(B0, 1, 0); PG8_LDB(B1, 1, 1); PG8_SCHED; PG8_LDA(At, 1, 0); PG8_STAGE(PG8_SA(0, 1), a2, x10, x11);
            PG8_WAIT_V(8); PG8_WAIT_L(0); PG8_BAR; PG8_MMA(0, 0, At, B0); PG8_MMA(0, 1, At, B1); PG8_BAR; PG8_SCHED;
            PG8_LDA(At, 1, 1); PG8_STAGE(PG8_SB(1, 0), b3, voffB[0][0], voffB[0][1]); PG8_STAGE(PG8_SB(1, 1), b3, voffB[1][0], voffB[1][1]); PG8_STAGE(PG8_SA(1, 0), a3, x00, x01);
            PG8_WAIT_V(8); PG8_WAIT_L(0); PG8_BAR; PG8_MMA(1, 0, At, B0); PG8_MMA(1, 1, At, B1); PG8_BAR; PG8_SCHED;
        }
        if constexpr (ALIGN_EPI) { if (wr == 0) PG8_BAR; }
        E(acc, cur, wr, wc, fr, fq);
        if (!has_next) break;
#pragma unroll
        for (int a = 0; a < 2; ++a)
#pragma unroll
            for (int b = 0; b < 2; ++b)
#pragma unroll
                for (int m = 0; m < 4; ++m)
#pragma unroll
                    for (int n = 0; n < 2; ++n) acc[a][b][m][n] = (f32x4){0.f, 0.f, 0.f, 0.f};
        cur = nxt; cA = nA; cB = nB; ++ui;
        if constexpr (Prob::GATHER) {
#pragma unroll
        for (int h = 0; h < 2; ++h)
#pragma unroll
            for (int i = 0; i < 2; ++i) cva[h][i] = nva[h][i]; }
        if constexpr (ALIGN_EPI) { if (wr == 1) PG8_BAR; }
    }
    PG8_WAIT_V(0);
    if constexpr (!ALIGN_EPI) { if (wr == 0) PG8_BAR; }
    PG8_BAR;
#undef PG8_SA
#undef PG8_SB
#undef PG8_STAGE
#undef PG8_LDA
#undef PG8_LDB
#undef PG8_MMA
#undef PG8_WAIT_V
#undef PG8_WAIT_L
#undef PG8_BAR
#undef PG8_SCHED
}

__device__ __forceinline__ void dense_offsets(int K, unsigned (&va)[2][2], int tid) {
#pragma unroll
    for (int i = 0; i < 2; ++i) { int R, C; stage_rc(tid * 16 + i * 8192, R, C); va[0][i] = (unsigned)(R * K + C) * 2u; va[1][i] = (unsigned)((R + HALF) * K + C) * 2u; }
}
}
struct ProbDense {
    int K; const bf16* A; const bf16* Bt; pg8::StaticOrder S;
    __device__ __forceinline__ bool next(int i, pg8::Unit& u) const { u.e = 0; u.lrow0 = 0; u.valid = 256; return S.map(i, u.pm, u.pn); }
    static constexpr bool GATHER = false;
    __device__ __forceinline__ const char* a_base(const pg8::Unit& u) const { return (const char*)(A + (size_t)u.pm * 256 * K); }
    __device__ __forceinline__ void a_setup(const pg8::Unit& u, const char*& base, unsigned (&va)[2][2], int tid) const { base = a_base(u); pg8::dense_offsets(K, va, tid); }
    __device__ __forceinline__ const char* b_base(const pg8::Unit& u) const { return (const char*)(Bt + (size_t)u.pn * 256 * K); }
};

struct EpiQKV {
    static constexpr bool PERM = true;
    bf16* Q; bf16* Kb; bf16* Vb; const float* cs;
    __device__ __forceinline__ void operator()(const f32x4 (&acc)[2][2][4][2], const pg8::Unit& u, int wr, int wc, int fr_, int fq_) const {
        int fr = fr_, fq = fq_; asm volatile("" : "+v"(fr), "+v"(fq));
        const int row0 = u.pm * 256 + wr * 64 + fr;
        bf16* dst; int ldc, colt; float sc = 1.f; bool rope = (u.pm < ML / 256);
        if (u.pn < 8) { dst = Q; ldc = DM; colt = u.pn * 256; sc = QSCALE; }
        else if (u.pn < 10) { dst = Kb; ldc = 512; colt = (u.pn - 8) * 256; }
        else { dst = Vb; ldc = 512; colt = (u.pn - 10) * 256; rope = false; }
        const int p0 = wc * 32 + fq * 8;
        const int i0 = (p0 & 63) >> 1;
#pragma unroll
        for (int ai = 0; ai < 2; ++ai) {
            f32x4 ca[4], cb[4];
#pragma unroll
            for (int m = 0; m < 4; ++m) { const int row = row0 + ai * 128 + m * 16, t = row & (SEQ - 1), pos = (wc < 2) ? (t >> 6) : (t & 63);
                ca[m] = (f32x4){1.f, 0.f, 1.f, 0.f}; cb[m] = ca[m];
                if (rope) { const f32x4* cp = (const f32x4*)(cs + (size_t)(pos * 32 + i0) * 2); ca[m] = cp[0]; cb[m] = cp[1]; } }
#pragma unroll
            for (int m = 0; m < 4; ++m) {
                const int row = row0 + ai * 128 + m * 16;
                bf16* rowp = dst + (size_t)row * ldc + colt + wc * 32 + fq * 8;
#pragma unroll
                for (int bj = 0; bj < 2; ++bj) {
                    const f32x4 v0 = acc[ai][bj][m][0], v1 = acc[ai][bj][m][1];
                    const float o0 = (v0[0] * ca[m][0] - v0[1] * ca[m][1]) * sc, o1 = (v0[1] * ca[m][0] + v0[0] * ca[m][1]) * sc;
                    const float o2 = (v0[2] * ca[m][2] - v0[3] * ca[m][3]) * sc, o3 = (v0[3] * ca[m][2] + v0[2] * ca[m][3]) * sc;
                    const float o4 = (v1[0] * cb[m][0] - v1[1] * cb[m][1]) * sc, o5 = (v1[1] * cb[m][0] + v1[0] * cb[m][1]) * sc;
                    const float o6 = (v1[2] * cb[m][2] - v1[3] * cb[m][3]) * sc, o7 = (v1[3] * cb[m][2] + v1[2] * cb[m][3]) * sc;
                    u32x4 w; w.x = cvtpk(o0, o1); w.y = cvtpk(o2, o3); w.z = cvtpk(o4, o5); w.w = cvtpk(o6, o7);
                    *(u32x4*)(rowp + bj * 128) = w;
                }
            }
            asm volatile("" ::: "memory");
        }
    }
};

struct EpiWOut {
    static constexpr bool PERM = true;
    bf16* V; const float* xl; const float* xc; const bf16* xb; const float* mods;
    __device__ __forceinline__ void operator()(const f32x4 (&acc)[2][2][4][2], const pg8::Unit& u, int wr, int wc, int fr_, int fq_) const {
        int fr = fr_, fq = fq_; asm volatile("" : "+v"(fr), "+v"(fq));
        const int row0 = u.pm * 256 + wr * 64 + fr, col0 = u.pn * 256 + wc * 32 + 8 * fq;
        const int mr = u.pm < ML / 256 ? (u.pm >> 3) : 16;
        const float* g1 = mods + (size_t)mr * MODN + 2 * DM + col0;
        f32x4 gv[2][2];
#pragma unroll
        for (int bj = 0; bj < 2; ++bj)
#pragma unroll
            for (int n = 0; n < 2; ++n) gv[bj][n] = *(const f32x4*)(g1 + bj * 128 + n * 4);
#pragma unroll
        for (int ai = 0; ai < 2; ++ai) {
            f32x4 xr0[4][2], xr1[4][2];
#pragma unroll
            for (int m = 0; m < 4; ++m) { const int row = row0 + ai * 128 + m * 16;
#pragma unroll
                for (int bj = 0; bj < 2; ++bj) {
                    if (xl) { const float* xr = (row < ML ? xl + (size_t)row * DM : xc + (size_t)(row - ML) * DM) + col0 + bj * 128; xr0[m][bj] = *(const f32x4*)xr; xr1[m][bj] = *(const f32x4*)(xr + 4); }
                    else { const u32x4 xw = *(const u32x4*)(xb + (size_t)row * DM + col0 + bj * 128); xr0[m][bj] = (f32x4){bflo(xw.x), bfhi(xw.x), bflo(xw.y), bfhi(xw.y)}; xr1[m][bj] = (f32x4){bflo(xw.z), bfhi(xw.z), bflo(xw.w), bfhi(xw.w)}; } } }
#pragma unroll
            for (int m = 0; m < 4; ++m) { const int row = row0 + ai * 128 + m * 16; bf16* vr = V + (size_t)row * DM + col0;
#pragma unroll
                for (int bj = 0; bj < 2; ++bj) {
                    const f32x4 v0 = xr0[m][bj] * ALPHA + gv[bj][0] * acc[ai][bj][m][0], v1 = xr1[m][bj] * ALPHA + gv[bj][1] * acc[ai][bj][m][1];
                    u32x4 o; o.x = cvtpk(v0[0], v0[1]); o.y = cvtpk(v0[2], v0[3]); o.z = cvtpk(v1[0], v1[1]); o.w = cvtpk(v1[2], v1[3]);
                    *(u32x4*)(vr + bj * 128) = o; } }
            asm volatile("" ::: "memory");
        }
    }
};

struct EpiF32 {
    static constexpr bool PERM = false;
    float* C; int ldc;
    __device__ __forceinline__ void operator()(const f32x4 (&acc)[2][2][4][2], const pg8::Unit& u, int wr, int wc, int fr_, int fq_) const {
        int fr = fr_, fq = fq_; asm volatile("" : "+v"(fr), "+v"(fq));
        const int row0 = u.pm * 256 + wr * 64 + fr, col0 = u.pn * 256 + wc * 32 + 4 * fq;
#pragma unroll
        for (int ai = 0; ai < 2; ++ai)
#pragma unroll
            for (int m = 0; m < 4; ++m) { float* rowp = C + (size_t)(row0 + ai * 128 + m * 16) * ldc + col0;
#pragma unroll
                for (int bj = 0; bj < 2; ++bj)
#pragma unroll
                    for (int n = 0; n < 2; ++n) *(f32x4*)(rowp + bj * 128 + n * 16) = acc[ai][bj][m][n]; }
    }
};

struct MoeTables { const LAS int* toff; const LAS int* cnt; };
__device__ __forceinline__ bool moe_unit(const MoeTables& Tb, long L, int nct, pg8::Unit& u) {
    const int ntile = Tb.toff[32];
    if (L >= (long)ntile * nct) return false;
    const int rt = (int)(L / nct); u.pm = rt; u.pn = (int)(L % nct);
    int e = 0;
#pragma unroll
    for (int j = 1; j < 32; ++j) e += (rt >= Tb.toff[j]) ? 1 : 0;
    u.e = e; u.lrow0 = (rt - Tb.toff[e]) * 256; const int rem = Tb.cnt[e] - u.lrow0; u.valid = rem < 256 ? rem : 256;
    return true;
}
struct ProbGU {
    int K; const bf16* A; const bf16* Bt; const unsigned* list; MoeTables Tb; int G, c;
    __device__ __forceinline__ bool next(int i, pg8::Unit& u) const { return moe_unit(Tb, (long)i * G + c, 4, u); }
    static constexpr bool GATHER = true;
    __device__ __forceinline__ const char* a_base(const pg8::Unit&) const { return (const char*)A; }
    __device__ __forceinline__ void a_setup(const pg8::Unit& u, const char*& base, unsigned (&va)[2][2], int tid) const {
        base = (const char*)A; const unsigned* lp = list + (size_t)u.e * LISTCAP + u.lrow0;
#pragma unroll
        for (int i = 0; i < 2; ++i) { int R, C; pg8::stage_rc(tid * 16 + i * 8192, R, C);
#pragma unroll
            for (int h = 0; h < 2; ++h) { const int r = h * 128 + R; const unsigned raw = lp[r];
                const unsigned ent = (r < u.valid) ? raw : 0u; va[h][i] = ((ent >> 1) * (unsigned)K + (unsigned)C) * 2u; } }
    }
    __device__ __forceinline__ const char* b_base(const pg8::Unit& u) const { return (const char*)(Bt + ((size_t)u.e * 1024 + (size_t)u.pn * 256) * K); }
};
struct EpiGU {
    static constexpr bool PERM = true;
    bf16* HID;
    __device__ __forceinline__ void operator()(const f32x4 (&acc)[2][2][4][2], const pg8::Unit& u, int wr, int wc, int fr_, int fq_) const {
        int fr = fr_, fq = fq_; asm volatile("" : "+v"(fr), "+v"(fq));
        const int row0 = u.pm * 256 + wr * 64 + fr, col0 = u.pn * 128 + wc * 32 + fq * 8;
#pragma unroll
        for (int ai = 0; ai < 2; ++ai)
#pragma unroll
            for (int m = 0; m < 4; ++m) {
                const f32x4 g0 = acc[ai][0][m][0], g1 = acc[ai][0][m][1], u0 = acc[ai][1][m][0], u1 = acc[ai][1][m][1];
                u32x4 w; w.x = cvtpk(silu_f(g0[0]) * u0[0], silu_f(g0[1]) * u0[1]); w.y = cvtpk(silu_f(g0[2]) * u0[2], silu_f(g0[3]) * u0[3]);
                w.z = cvtpk(silu_f(g1[0]) * u1[0], silu_f(g1[1]) * u1[1]); w.w = cvtpk(silu_f(g1[2]) * u1[2], silu_f(g1[3]) * u1[3]);
                *(u32x4*)(HID + (size_t)(row0 + ai * 128 + m * 16) * MOEH + col0) = w;
            }
    }
};
struct ProbDown {
    int K; const bf16* A; const bf16* Bt; MoeTables Tb; int G, c;
    __device__ __forceinline__ bool next(int i, pg8::Unit& u) const { return moe_unit(Tb, (long)i * G + c, 8, u); }
    static constexpr bool GATHER = false;
    __device__ __forceinline__ const char* a_base(const pg8::Unit& u) const { return (const char*)(A + (size_t)u.pm * 256 * K); }
    __device__ __forceinline__ void a_setup(const pg8::Unit& u, const char*& base, unsigned (&va)[2][2], int tid) const { base = a_base(u); pg8::dense_offsets(K, va, tid); }
    __device__ __forceinline__ const char* b_base(const pg8::Unit& u) const { return (const char*)(Bt + ((size_t)u.e * DM + (size_t)u.pn * 256) * K); }
};
struct EpiDown {
    static constexpr bool PERM = true;
    bf16* Y2; const unsigned* list; const float* wlist;
    __device__ __forceinline__ void operator()(const f32x4 (&acc)[2][2][4][2], const pg8::Unit& u, int wr, int wc, int fr_, int fq_) const {
        int fr = fr_, fq = fq_; asm volatile("" : "+v"(fr), "+v"(fq));
        const int col0 = u.pn * 256 + wc * 32 + fq * 8;
        const size_t lb = (size_t)u.e * LISTCAP + u.lrow0;
        unsigned ent[8]; float wt[8];
#pragma unroll
        for (int i = 0; i < 8; ++i) { const int lr = (i >> 2) * 128 + wr * 64 + (i & 3) * 16 + fr; const bool ok = lr < u.valid; const unsigned er = list[lb + lr]; const float wr_ = wlist[lb + lr];
            ent[i] = ok ? er : 0xffffffffu; wt[i] = ok ? wr_ : 0.f; }
#pragma unroll
        for (int ai = 0; ai < 2; ++ai)
#pragma unroll
            for (int m = 0; m < 4; ++m) {
                const unsigned en = ent[ai * 4 + m]; const float w = wt[ai * 4 + m];
                if (en != 0xffffffffu) {
                    bf16* rowp = Y2 + ((size_t)(en & 1u) * MA + (en >> 1)) * DM + col0;
#pragma unroll
                    for (int bj = 0; bj < 2; ++bj) { const f32x4 v0 = acc[ai][bj][m][0] * w, v1 = acc[ai][bj][m][1] * w;
                        u32x4 o; o.x = cvtpk(v0[0], v0[1]); o.y = cvtpk(v0[2], v0[3]); o.z = cvtpk(v1[0], v1[1]); o.w = cvtpk(v1[2], v1[3]);
                        *(u32x4*)(rowp + bj * 128) = o; }
                }
            }
    }
};

struct ProbProj {
    int K; const bf16* A; const bf16* Bt; pg8::StaticOrder S; int G, c;
    __device__ __forceinline__ bool next(int i, pg8::Unit& u) const {
        u.e = 0; u.lrow0 = 0; u.valid = 256;
        if (S.map(i, u.pm, u.pn)) return true;
        const long L = (long)i * G + c - S.nwg; if (L < 0 || L >= 16 * 12) return false;
        u.pm = ML / 256 + (int)(L / 12); u.pn = 4 + (int)(L % 12); return true;
    }
    static constexpr bool GATHER = false;
    __device__ __forceinline__ const char* a_base(const pg8::Unit& u) const { return (const char*)(A + (size_t)u.pm * 256 * K); }
    __device__ __forceinline__ void a_setup(const pg8::Unit& u, const char*& base, unsigned (&va)[2][2], int tid) const { base = a_base(u); pg8::dense_offsets(K, va, tid); }
    __device__ __forceinline__ const char* b_base(const pg8::Unit& u) const { return (const char*)(Bt + (size_t)u.pn * 256 * K); }
};
struct EpiProj {
    static constexpr bool PERM = true;
    bf16* GQ; bf16* GK; bf16* GV; bf16* GR; float* GU;
    __device__ __forceinline__ void operator()(const f32x4 (&acc)[2][2][4][2], const pg8::Unit& u, int wr, int wc, int fr_, int fq_) const {
        int fr = fr_, fq = fq_; asm volatile("" : "+v"(fr), "+v"(fq));
        const int row0 = u.pm * 256 + wr * 64 + fr, cw = wc * 32 + fq * 8;
        if (u.pn == 24) {
            if (wc == 0) {
#pragma unroll
                for (int ai = 0; ai < 2; ++ai)
#pragma unroll
                    for (int m = 0; m < 4; ++m) { float* rp = GU + (size_t)(row0 + ai * 128 + m * 16) * 32 + fq * 8;
                        *(f32x4*)rp = acc[ai][0][m][0]; *(f32x4*)(rp + 4) = acc[ai][0][m][1]; }
            }
            return;
        }
        bf16* dst; int ldc, colt; bool act = false;
        if (u.pn < 4) { dst = GQ; ldc = 1024; colt = u.pn * 256; }
        else if (u.pn < 8) { dst = GK; ldc = 1024; colt = (u.pn - 4) * 256; }
        else if (u.pn < 16) { dst = GV; ldc = 2048; colt = (u.pn - 8) * 256; }
        else { dst = GR; ldc = 2048; colt = (u.pn - 16) * 256; act = true; }
#pragma unroll
        for (int ai = 0; ai < 2; ++ai)
#pragma unroll
            for (int m = 0; m < 4; ++m) { bf16* rowp = dst + (size_t)(row0 + ai * 128 + m * 16) * ldc + colt + cw;
#pragma unroll
                for (int bj = 0; bj < 2; ++bj) { f32x4 v0 = acc[ai][bj][m][0], v1 = acc[ai][bj][m][1];
                    if (act) {
#pragma unroll
                        for (int j = 0; j < 4; ++j) { v0[j] = silu_f(v0[j]); v1[j] = silu_f(v1[j]); } }
                    u32x4 o; o.x = cvtpk(v0[0], v0[1]); o.y = cvtpk(v0[2], v0[3]); o.z = cvtpk(v1[0], v1[1]); o.w = cvtpk(v1[2], v1[3]);
                    *(u32x4*)(rowp + bj * 128) = o; }
                asm volatile("" ::: "memory"); }
    }
};
__device__ __forceinline__ void ph_mods(Frame& F) {
    LAS float* S = (LAS float*)F.lds;
    const float* c = F.in[I_C]; const float* cc = F.in[I_CCTX]; const float* mw = F.in[I_MODW]; const float* mb = F.in[I_MODB];
    float* mods = (float*)(F.ws + WS_MODS);
    for (int item = blockIdx.x; item < 2 * 96; item += F.G) {
        const int l = item / 96, n0 = (item % 96) * 128;
        __syncthreads();
        for (int idx = F.tid; idx < 17 * DM; idx += NTHREADS) { const int r = idx >> 11, k = idx & (DM - 1); const float v = r < 16 ? c[r * DM + k] : cc[k]; S[idx] = v / (1.f + __expf(-v)); }
        __syncthreads();
        const int g = F.tid & 31, ks = F.tid >> 5;
        f32x4 acc[17];
#pragma unroll
        for (int r = 0; r < 17; ++r) acc[r] = (f32x4){0.f, 0.f, 0.f, 0.f};
        const float* w = mw + (size_t)l * DM * MODN + n0 + 4 * g;
#pragma unroll 4
        for (int i = 0; i < 32; ++i) { const int k = ks * 128 + 4 * i; f32x4 wv[4];
#pragma unroll
            for (int q = 0; q < 4; ++q) wv[q] = *(const f32x4*)(w + (size_t)(k + q) * MODN);
#pragma unroll
            for (int r = 0; r < 17; ++r) { const f32x4 sv = *(const LAS f32x4*)(S + r * DM + k); acc[r] += wv[0] * sv[0]; acc[r] += wv[1] * sv[1]; acc[r] += wv[2] * sv[2]; acc[r] += wv[3] * sv[3]; } }
#pragma unroll
        for (int r = 0; r < 17; ++r)
#pragma unroll
            for (int j = 0; j < 4; ++j) acc[r][j] += __shfl_xor(acc[r][j], 32);
        __syncthreads();
        LAS f32x4* red = (LAS f32x4*)F.lds;
        if (F.lane < 32) {
#pragma unroll
            for (int r = 0; r < 17; ++r) red[(F.wave * 17 + r) * 32 + g] = acc[r];
        }
        __syncthreads();
        for (int o = F.tid; o < 17 * 32; o += NTHREADS) { const int r = o >> 5, gg = o & 31; f32x4 s = *(const f32x4*)(mb + (size_t)l * MODN + n0 + 4 * gg);
#pragma unroll
            for (int wv = 0; wv < 8; ++wv) s += red[(wv * 17 + r) * 32 + gg];
            *(f32x4*)(mods + ((size_t)(l * 17 + r) * MODN + n0 + 4 * gg)) = s; }
    }
    __syncthreads();
}

template <class RowMap>
__device__ __forceinline__ void conv_item(const float* W, int ldw, int K, bf16* WT, const RowMap& rm, float scale, LAS float* scr, int nblk, int item, int lane) {
    const int kb = item / nblk, nb = item % nblk, k0 = 64 * kb, n0 = 64 * nb, lr = lane >> 4, lg = lane & 15;
    f32x4 v[16];
#pragma unroll
    for (int i = 0; i < 16; ++i) v[i] = *(const f32x4*)(W + (size_t)(k0 + 4 * i + lr) * ldw + n0 + 4 * lg);
#pragma unroll
    for (int i = 0; i < 16; ++i) { LAS float* d = scr + (4 * i + lr) * 65 + 4 * lg; d[0] = v[i][0]; d[1] = v[i][1]; d[2] = v[i][2]; d[3] = v[i][3]; }
    LDS_WAIT(); asm volatile("" ::: "memory");
    const int c = lane & 7;
#pragma unroll
    for (int j = 0; j < 8; ++j) { const int n = (lane >> 3) + 8 * j; const LAS float* s = scr + (8 * c) * 65 + n;
        u32x4 o; o.x = cvtpk(s[0 * 65] * scale, s[1 * 65] * scale); o.y = cvtpk(s[2 * 65] * scale, s[3 * 65] * scale); o.z = cvtpk(s[4 * 65] * scale, s[5 * 65] * scale); o.w = cvtpk(s[6 * 65] * scale, s[7 * 65] * scale);
        *(u32x4*)(WT + (size_t)rm(n0 + n) * K + k0 + 8 * c) = o; }
    LDS_WAIT(); asm volatile("" ::: "memory");
}
struct RmId { __device__ __forceinline__ int operator()(int n) const { return n; } };
struct RmQKV {
    __device__ __forceinline__ int operator()(int n) const { if (n >= 2560) return n; const int dd = n & 127, base = n - dd, hh = dd >> 6, d2 = dd & 63; return base + hh * 64 + 2 * (d2 & 31) + (d2 >> 5); } };
struct RmGU { int up; __device__ __forceinline__ int operator()(int n) const { return 256 * (n >> 7) + 128 * up + (n & 127); } };

constexpr int CV_IG = (DM / 64) * (MOEH / 64), CV_ID = (MOEH / 64) * (DM / 64), CV_MOE_ITEMS = NEXP * (2 * CV_IG + CV_ID);
__device__ __forceinline__ void conv_moe_item(Frame& F, int l, int it, LAS float* scr) {
    bf16* WGU = (bf16*)(F.ws + WS_WGU); bf16* WD = (bf16*)(F.ws + WS_WD);
    const float* wg = F.in[I_MWG] + (size_t)l * NEXP * DM * MOEH; const float* wu = F.in[I_MWU] + (size_t)l * NEXP * DM * MOEH; const float* wd = F.in[I_MWD] + (size_t)l * NEXP * MOEH * DM;
    const int e = it / (2 * CV_IG + CV_ID); int r = it % (2 * CV_IG + CV_ID);
    if (r < CV_IG) { conv_item(wg + (size_t)e * DM * MOEH, MOEH, DM, WGU + (size_t)e * 1024 * DM, RmGU{0}, 1.f, scr, MOEH / 64, r, F.lane); return; } r -= CV_IG;
    if (r < CV_IG) { conv_item(wu + (size_t)e * DM * MOEH, MOEH, DM, WGU + (size_t)e * 1024 * DM, RmGU{1}, 1.f, scr, MOEH / 64, r, F.lane); return; } r -= CV_IG;
    conv_item(wd + (size_t)e * MOEH * DM, DM, MOEH, WD + (size_t)e * DM * MOEH, RmId{}, 1.f, scr, DM / 64, r, F.lane);
}
__device__ __forceinline__ void ph_conv_moe(Frame& F, int l) {
    LAS float* scr = (LAS float*)(F.lds + F.wave * 16640);
    const int gw = F.vcu * NWAVES + F.wave, NGW = F.G * NWAVES;
    for (int it = gw; it < CV_MOE_ITEMS; it += NGW) conv_moe_item(F, l, it, scr);
}
constexpr int CQ_Q = (DM / 64) * (NQKV / 64), CQ_O = (DM / 64) * (DM / 64), CQ_N = (DM / 64) * (6144 / 64), CQ_DENSE = 2 * CQ_O + CQ_N;
constexpr int CV_E0_SPLIT = 22, CV_E0_HEAD = CV_E0_SPLIT * (2 * CV_IG + CV_ID);
__device__ __forceinline__ void conv_dense_item(Frame& F, int r, LAS float* scr) {
    if (r < CQ_O) { conv_item(F.in[I_WOA], DM, DM, (bf16*)(F.ws + WS_WO), RmId{}, 1.f, scr, DM / 64, r, F.lane); return; } r -= CQ_O;
    if (r < CQ_O) { conv_item(F.in[I_WOG], DM, DM, (bf16*)(F.ws + WS_WO2), RmId{}, 1.f, scr, DM / 64, r, F.lane); return; } r -= CQ_O;
    const int nb = r % (6144 / 64);
    conv_item(F.in[I_WIN], 6144, DM, (bf16*)(F.ws + WS_WIN), RmId{}, nb < 16 ? 0.0625f : 1.f, scr, 6144 / 64, r, F.lane);
}
__device__ __forceinline__ void conv_static(Frame& F, int kind, int lo, int hi, int Gs, int cs) {
    LAS float* scr = (LAS float*)(F.lds + F.wave * 16640);
    for (int it = lo + cs * NWAVES + F.wave; it < hi; it += Gs * NWAVES) { if (kind == 0) conv_dense_item(F, it, scr); else conv_moe_item(F, 0, it, scr); }
}
__device__ __forceinline__ void ph_conv0(Frame& F) {
    LAS float* scr = (LAS float*)(F.lds + F.wave * 16640);
    bf16* WQKV = (bf16*)(F.ws + WS_WQKV); bf16* WIN = (bf16*)(F.ws + WS_WIN); bf16* WR = (bf16*)(F.ws + WS_WR);
    constexpr int I_ALL = CQ_Q + CV_E0_HEAD;
    for (;;) {
        int base = 0; if (F.lane == 0) base = (int)atomicAdd(F.ctl + CW_WQ, 8u);
        base = __builtin_amdgcn_readfirstlane(base);
        if (base >= I_ALL) break;
        for (int it = base; it < base + 8 && it < I_ALL; ++it) {
            if (it < CQ_Q) conv_item(F.in[I_WQKV], NQKV, DM, WQKV, RmQKV{}, 1.f, scr, NQKV / 64, it, F.lane);
            else conv_moe_item(F, 0, it - CQ_Q, scr);
        }
    }
    const size_t gt = (size_t)(blockIdx.x) * NTHREADS + F.tid, gn = (size_t)F.G * NTHREADS;
    for (size_t i = gt; i < (size_t)224 * DM; i += gn) WIN[(size_t)(6176) * DM + i] = 0;
    for (size_t i = gt; i < (size_t)2 * DM * 16; i += gn) { const int d = (int)(i / (DM * 16)), k = (int)((i / 16) % DM), r = (int)(i % 16); WIN[(size_t)(6144 + 16 * d + r) * DM + k] = f2bf(F.in[I_GW1][i]); }
    for (size_t i = gt; i < (size_t)2 * 36 * DM; i += gn) { const int l = (int)(i / (36 * DM)), j = (int)((i / DM) % 36), k = (int)(i % DM);
        const float w = j < 4 ? F.in[I_MGW][((size_t)l * DM + k) * 4 + j] : F.in[I_MRW][((size_t)l * DM + k) * 32 + (j - 4)];
        const unsigned short hi = f2bf(w); const float lo = w - bf2f(hi);
        WR[((size_t)l * 256 + j) * DM + k] = hi; WR[((size_t)l * 256 + 36 + j) * DM + k] = f2bf(lo); }
    for (size_t i = gt; i < (size_t)2 * 184 * DM; i += gn) { const int l = (int)(i / (184 * DM)); const size_t o = i % ((size_t)184 * DM); WR[((size_t)l * 256 + 72) * DM + o] = 0; }
    float* cs = (float*)(F.ws + WS_ROPE);
    for (size_t i = gt; i < 64 * 32; i += gn) { const int pos = (int)(i >> 5), fi = (int)(i & 31); const float inv = powf(10000.f, -(float)(2 * fi) / 64.f); const float ang = (float)pos * inv;
        cs[2 * i] = cosf(ang); cs[2 * i + 1] = sinf(ang); }
}

__device__ __forceinline__ void row_load_f32(const float* p, int lane, float (&v)[32]) {
#pragma unroll
    for (int j = 0; j < 4; ++j) { const f32x4 a = *(const f32x4*)(p + 8 * lane + 512 * j), b = *(const f32x4*)(p + 8 * lane + 512 * j + 4);
        v[8 * j] = a[0]; v[8 * j + 1] = a[1]; v[8 * j + 2] = a[2]; v[8 * j + 3] = a[3]; v[8 * j + 4] = b[0]; v[8 * j + 5] = b[1]; v[8 * j + 6] = b[2]; v[8 * j + 7] = b[3]; }
}
__device__ __forceinline__ void row_load_bf16(const bf16* p, int lane, float (&v)[32]) {
#pragma unroll
    for (int j = 0; j < 4; ++j) { const u32x4 a = *(const u32x4*)(p + 8 * lane + 512 * j);
#pragma unroll
        for (int q = 0; q < 4; ++q) { v[8 * j + 2 * q] = bflo(a[q]); v[8 * j + 2 * q + 1] = bfhi(a[q]); } }
}
__device__ __forceinline__ void row_store_bf16(bf16* p, int lane, const float (&v)[32]) {
#pragma unroll
    for (int j = 0; j < 4; ++j) { u32x4 o; o.x = cvtpk(v[8 * j], v[8 * j + 1]); o.y = cvtpk(v[8 * j + 2], v[8 * j + 3]); o.z = cvtpk(v[8 * j + 4], v[8 * j + 5]); o.w = cvtpk(v[8 * j + 6], v[8 * j + 7]);
        *(u32x4*)(p + 8 * lane + 512 * j) = o; }
}
__device__ __forceinline__ void row_store_f32(float* p, int lane, const float (&v)[32]) {
#pragma unroll
    for (int j = 0; j < 4; ++j) { *(f32x4*)(p + 8 * lane + 512 * j) = (f32x4){v[8 * j], v[8 * j + 1], v[8 * j + 2], v[8 * j + 3]}; *(f32x4*)(p + 8 * lane + 512 * j + 4) = (f32x4){v[8 * j + 4], v[8 * j + 5], v[8 * j + 6], v[8 * j + 7]}; }
}
__device__ __forceinline__ void row_ln(float (&v)[32], const float* g, const float* b, int lane) {
    float s = 0.f;
#pragma unroll
    for (int i = 0; i < 32; ++i) s += v[i];
    const float mean = wave_sum(s) * (1.f / DM); float q = 0.f;
#pragma unroll
    for (int i = 0; i < 32; ++i) { v[i] -= mean; q += v[i] * v[i]; }
    const float rstd = 1.f / sqrtf(wave_sum(q) * (1.f / DM) + LN_EPS);
    float gv[32], bv[32]; row_load_f32(g, lane, gv); row_load_f32(b, lane, bv);
#pragma unroll
    for (int i = 0; i < 32; ++i) v[i] = v[i] * rstd * gv[i] + bv[i];
}
__device__ __forceinline__ void row_mod(float (&v)[32], const float* sh, const float* sc, int lane) {
    float a[32], b[32]; row_load_f32(sc, lane, a); row_load_f32(sh, lane, b);
#pragma unroll
    for (int i = 0; i < 32; ++i) v[i] = v[i] * (a[i] + 1.f) + b[i];
}
__device__ __forceinline__ void ph_mod0(Frame& F) {
    const int gw = F.vcu * NWAVES + F.wave, NGW = F.G * NWAVES; bf16* HB = (bf16*)(F.ws + WS_HB);
    for (int m = gw; m < MA; m += NGW) {
        const float* xr = m < ML ? F.in[I_X] + (size_t)m * DM : F.in[I_CTX] + (size_t)(m - ML) * DM; const int mr = mod_row(m);
        float v[32]; row_load_f32(xr, F.lane, v); row_mod(v, mods_ptr(F, 0, mr, 0), mods_ptr(F, 0, mr, 1), F.lane); row_store_bf16(HB + (size_t)m * DM, F.lane, v);
    }
}
__device__ __forceinline__ void ph_ln1(Frame& F, int l) {
    const int gw = F.vcu * NWAVES + F.wave, NGW = F.G * NWAVES; bf16* HB = (bf16*)(F.ws + WS_HB); bf16* VX = (bf16*)(F.ws + WS_VX);
    const int M = l ? ML : MA; const float* g = F.in[I_LNG] + (size_t)(l * 2 + 0) * DM; const float* b = F.in[I_LNB] + (size_t)(l * 2 + 0) * DM;
    for (int m = gw; m < M; m += NGW) { const int mr = mod_row(m);
        float v[32]; row_load_bf16(VX + (size_t)m * DM, F.lane, v); row_ln(v, g, b, F.lane);
        row_store_bf16(VX + (size_t)m * DM, F.lane, v);
        row_mod(v, mods_ptr(F, l, mr, 3), mods_ptr(F, l, mr, 4), F.lane); row_store_bf16(HB + (size_t)m * DM, F.lane, v); }
}
__device__ __forceinline__ void ph_ln2(Frame& F, int l) {
    const int gw = F.vcu * NWAVES + F.wave, NGW = F.G * NWAVES; bf16* HB = (bf16*)(F.ws + WS_HB); const bf16* VX = (const bf16*)(F.ws + WS_VX); const bf16* Y2 = (const bf16*)(F.ws + WS_Y2);
    const int M = l ? ML : MA; const float* g = F.in[I_LNG] + (size_t)(l * 2 + 1) * DM; const float* b = F.in[I_LNB] + (size_t)(l * 2 + 1) * DM;
    for (int m = gw; m < M; m += NGW) { const int mr = mod_row(m);
        float v[32], ya[32], yb[32], g2[32]; row_load_bf16(VX + (size_t)m * DM, F.lane, v); row_load_bf16(Y2 + (size_t)m * DM, F.lane, ya); row_load_bf16(Y2 + ((size_t)MA + m) * DM, F.lane, yb); row_load_f32(mods_ptr(F, l, mr, 5), F.lane, g2);
#pragma unroll
        for (int i = 0; i < 32; ++i) v[i] = v[i] * ALPHA + g2[i] * (ya[i] + yb[i]);
        row_ln(v, g, b, F.lane);
        if (l == 1) row_store_f32(F.out + (size_t)m * DM, F.lane, v);
        else { if (m < ML) row_store_bf16((bf16*)F.out + (size_t)m * DM, F.lane, v);
            row_mod(v, mods_ptr(F, 1, mr, 0), mods_ptr(F, 1, mr, 1), F.lane); row_store_bf16(HB + (size_t)m * DM, F.lane, v); } }
}


constexpr int SK_RS = 272, SK_A = 32 * SK_RS;
template <int NB>
__device__ __forceinline__ void skinny_gemm(Frame& F, const bf16* A, const bf16* W, float* out, int ldo, int M, int Gs = 0, int cs = 0) {
    const int lane = F.lane, r32 = lane & 31, hi = lane >> 5, tid = F.tid, w = F.wave;
    LAS unsigned char* Al = F.lds + w * SK_A; LAS unsigned char* Wl = F.lds + NWAVES * SK_A;
    const int Gd = Gs > 0 ? Gs : F.G, cd = Gs > 0 ? cs : F.vcu;
    const int nblk = M / 32, npass = (nblk + NWAVES * Gd - 1) / (NWAVES * Gd);
    for (int pass = 0; pass < npass; ++pass) {
        const int blk = pass * NWAVES * Gd + w * Gd + cd; const bool have = blk < nblk;
        f32x16 acc[NB];
#pragma unroll
        for (int nb = 0; nb < NB; ++nb)
#pragma unroll
            for (int r = 0; r < 16; ++r) acc[nb][r] = 0.f;
        const char* ag = (const char*)A + ((size_t)blk * 32 + (lane >> 4)) * (DM * 2) + (lane & 15) * 16;
        const int al = (lane >> 4) * SK_RS + (lane & 15) * 16;
        u32x4 ra[3][8], rw[3][NB];
#define SK_LOAD(sl_, q_) do { if (have) { _Pragma("unroll") for (int i_ = 0; i_ < 8; ++i_) ra[q_][i_] = *(const u32x4*)(ag + (size_t)i_ * 4 * (DM * 2) + (sl_) * 256); } \
            _Pragma("unroll") for (int i_ = 0; i_ < NB; ++i_) { const int idx_ = tid + 512 * i_; rw[q_][i_] = *(const u32x4*)((const char*)W + (size_t)(idx_ >> 4) * (DM * 2) + (sl_) * 256 + (idx_ & 15) * 16); } } while (0)
#define SK_BAR() do { asm volatile("s_waitcnt lgkmcnt(0)" ::: "memory"); __builtin_amdgcn_s_barrier(); asm volatile("" ::: "memory"); } while (0)
        SK_LOAD(0, 0); SK_LOAD(1, 1);
#pragma unroll
        for (int sl = 0; sl < DM / 128; ++sl) {
            SK_BAR();
            if (have) {
#pragma unroll
                for (int i = 0; i < 8; ++i) *(LAS u32x4*)(Al + al + i * 4 * SK_RS) = ra[sl % 3][i]; }
#pragma unroll
            for (int i = 0; i < NB; ++i) { const int idx = tid + 512 * i; *(LAS u32x4*)(Wl + (idx >> 4) * SK_RS + (idx & 15) * 16) = rw[sl % 3][i]; }
            SK_BAR();
            if (sl + 2 < DM / 128) SK_LOAD(sl + 2, (sl + 2) % 3);
            if (have) {
#pragma unroll
                for (int ks = 0; ks < 8; ++ks) {
                    const bf16x8 a = *(const LAS bf16x8*)(Al + r32 * SK_RS + (16 * ks + 8 * hi) * 2);
#pragma unroll
                    for (int nb = 0; nb < NB; ++nb) { const bf16x8 b = *(const LAS bf16x8*)(Wl + (32 * nb + r32) * SK_RS + (16 * ks + 8 * hi) * 2); acc[nb] = MFMA32(a, b, acc[nb]); }
                } }
        }
#undef SK_BAR
#undef SK_LOAD
        if (have) {
#pragma unroll
            for (int nb = 0; nb < NB; ++nb)
#pragma unroll
                for (int r = 0; r < 16; ++r) out[(size_t)(blk * 32 + crow(r, hi)) * ldo + 32 * nb + r32] = acc[nb][r]; }
    }
    __syncthreads();
}

__device__ __forceinline__ void ph_topk(Frame& F, int l) {
    const int M = l ? ML : MA; const float* LOG = (const float*)(F.ws + WS_LOG); unsigned* list = (unsigned*)(F.ws + WS_LIST); float* wlist = (float*)(F.ws + WS_WLIST);
    const float* gb = F.in[I_MGB] + l * 4; const float* rb = F.in[I_MRB] + l * 32; unsigned* cnt = F.ctl + CW_CNT + l * 32 * CW_STRIDE;
    const int nblk = M / 32, nslot = ((nblk + NWAVES * F.G - 1) / (NWAVES * F.G)) * NWAVES;
    for (int i = F.tid >> 5; i < nslot; i += NTHREADS / 32) {
        const int blk = (i >> 3) * NWAVES * F.G + (i & 7) * F.G + F.vcu; if (blk >= nblk) continue;
        const int m = blk * 32 + (F.tid & 31);
        const float* lg = LOG + (size_t)m * 256; float v[72];
#pragma unroll
        for (int j = 0; j < 18; ++j) { const f32x4 t = __builtin_nontemporal_load((const f32x4*)(lg + 4 * j)); v[4 * j] = t[0]; v[4 * j + 1] = t[1]; v[4 * j + 2] = t[2]; v[4 * j + 3] = t[3]; }
        float gl[4]; int gi = 0;
#pragma unroll
        for (int j = 0; j < 4; ++j) gl[j] = v[j] + v[36 + j] + gb[j];
        float gm = gl[0];
#pragma unroll
        for (int j = 1; j < 4; ++j) if (gl[j] > gm) { gm = gl[j]; gi = j; }
        float den = 0.f;
#pragma unroll
        for (int j = 0; j < 4; ++j) den += __expf(gl[j] - gm);
        const float gw = 1.f / den;
        float el[8];
#pragma unroll
        for (int j = 0; j < 8; ++j) { float a = 0.f;
#pragma unroll
            for (int q = 0; q < 4; ++q) { const float x = v[4 + q * 8 + j] + v[40 + q * 8 + j]; a = (q == gi) ? x : a; }
            el[j] = a + rb[gi * 8 + j]; }
        int i0 = 0; float v0 = el[0];
#pragma unroll
        for (int j = 1; j < 8; ++j) if (el[j] > v0) { v0 = el[j]; i0 = j; }
        int i1 = -1; float v1 = -3.0e38f;
#pragma unroll
        for (int j = 0; j < 8; ++j) if (j != i0 && el[j] > v1) { v1 = el[j]; i1 = j; }
        const float e1 = __expf(v1 - v0), w0 = gw / (1.f + e1), w1 = gw * e1 / (1.f + e1);
        const int ea = gi * 8 + i0, eb = gi * 8 + i1;
        const unsigned pa = atomicAdd(cnt + ea * CW_STRIDE, 1u), pb = atomicAdd(cnt + eb * CW_STRIDE, 1u);
        list[(size_t)ea * LISTCAP + pa] = 2u * m; wlist[(size_t)ea * LISTCAP + pa] = w0;
        list[(size_t)eb * LISTCAP + pb] = 2u * m + 1u; wlist[(size_t)eb * LISTCAP + pb] = w1;
    }
}
__device__ __forceinline__ MoeTables moe_tables(Frame& F, int l) {
    LAS int* toff = (LAS int*)(F.lds + MISC_OFF + 256); LAS int* cn = (LAS int*)(F.lds + MISC_OFF + 512);
    __syncthreads();
    if (F.tid < 32) {
        const int e = F.tid; const int n = (int)__hip_atomic_load(F.ctl + CW_CNT + (l * 32 + e) * CW_STRIDE, RLX_AGENT); const int tl = (n + 255) >> 8;
        int inc = tl;
#pragma unroll
        for (int d = 1; d < 32; d <<= 1) { const int t = __shfl_up(inc, d, 32); if (e >= d) inc += t; }
        cn[e] = n; toff[e] = inc - tl; if (e == 31) toff[32] = inc; }
    __syncthreads();
    MoeTables T; T.toff = toff; T.cnt = cn; return T;
}

__device__ __forceinline__ void ph_gates(Frame& F) {
    const float* GU = (const float*)(F.ws + WS_GU); float* BF = (float*)(F.ws + WS_VX); float* BB = BF + (size_t)MA * 1024;
    const float* gw2 = F.in[I_GW2]; const float* gbp = F.in[I_GB];
    LAS float* us = (LAS float*)F.lds;
    for (int ch = blockIdx.x; ch < MA / 32; ch += F.G) {
        __syncthreads();
        for (int i = F.tid; i < 1024; i += NTHREADS) us[i] = GU[(size_t)ch * 1024 + i];
        __syncthreads();
#pragma unroll 1
        for (int j = 0; j < 2; ++j) { const int c = F.tid + 512 * j;
#pragma unroll 1
            for (int d = 0; d < 2; ++d) {
                float w[16]; const float bias = gbp[d * 1024 + c];
#pragma unroll
                for (int r = 0; r < 16; ++r) w[r] = gw2[((size_t)d * 16 + r) * 1024 + c];
                float lgv[32];
#pragma unroll
                for (int t = 0; t < 32; ++t) { float p = bias; const LAS f32x4* up = (const LAS f32x4*)(us + t * 32 + d * 16);
#pragma unroll
                    for (int r4 = 0; r4 < 4; ++r4) { const f32x4 u4 = up[r4]; p += u4[0] * w[4 * r4] + u4[1] * w[4 * r4 + 1] + u4[2] * w[4 * r4 + 2] + u4[3] * w[4 * r4 + 3]; }
                    lgv[t] = (fminf(p, 0.f) - __logf(1.f + __expf(-fabsf(p)))) * 0.0625f; }
                float* dst = (d == 0 ? BF : BB) + (size_t)ch * 32 * 1024 + c;
                if (d == 0) { float a = 0.f;
#pragma unroll
                    for (int t = 0; t < 32; ++t) { a += lgv[t]; dst[(size_t)t * 1024] = a; } }
                else { float a = 0.f;
#pragma unroll
                    for (int t = 31; t >= 0; --t) { a += lgv[t]; dst[(size_t)t * 1024] = a; } }
            } }
    }
    __syncthreads();
}

__device__ __forceinline__ void ph_readout(Frame& F) {
    const int gw = F.vcu * NWAVES + F.wave, NGW = F.G * NWAVES;
    const bf16* OF = (const bf16*)(F.ws + WS_HB); const bf16* OB = (const bf16*)(F.ws + WS_OB); const bf16* GR = (const bf16*)(F.ws + WS_GR); bf16* A2 = (bf16*)(F.ws + WS_A2); const float* ng = F.in[I_NG];
    for (int m = gw; m < ML; m += NGW) {
        const size_t off = (size_t)m * DM + F.lane * 32;
        float o[32]; float ss = 0.f;
#pragma unroll
        for (int j = 0; j < 4; ++j) { const u32x4 a = *(const u32x4*)(OF + off + 8 * j), b = *(const u32x4*)(OB + off + 8 * j);
#pragma unroll
            for (int q = 0; q < 4; ++q) { const float lo = bflo(a[q]) + bflo(b[q]), hi = bfhi(a[q]) + bfhi(b[q]); o[8 * j + 2 * q] = lo; o[8 * j + 2 * q + 1] = hi; ss += lo * lo + hi * hi; } }
        ss += __shfl_xor(ss, 1); ss += __shfl_xor(ss, 2); ss += __shfl_xor(ss, 4); ss += __shfl_xor(ss, 8);
        const float rs = 1.f / sqrtf(ss * (1.f / GDV) + RMS_EPS);
        const int hc = (F.lane & 15) * 32;
#pragma unroll
        for (int j = 0; j < 4; ++j) { const u32x4 r = *(const u32x4*)(GR + off + 8 * j); const f32x4 g0 = *(const f32x4*)(ng + hc + 8 * j), g1 = *(const f32x4*)(ng + hc + 8 * j + 4);
            u32x4 w; w.x = cvtpk(o[8 * j] * rs * g0[0] * bflo(r.x), o[8 * j + 1] * rs * g0[1] * bfhi(r.x)); w.y = cvtpk(o[8 * j + 2] * rs * g0[2] * bflo(r.y), o[8 * j + 3] * rs * g0[3] * bfhi(r.y));
            w.z = cvtpk(o[8 * j + 4] * rs * g1[0] * bflo(r.z), o[8 * j + 5] * rs * g1[1] * bfhi(r.z)); w.w = cvtpk(o[8 * j + 6] * rs * g1[2] * bflo(r.w), o[8 * j + 7] * rs * g1[3] * bfhi(r.w));
            *(u32x4*)(A2 + off + 8 * j) = w; }
    }
}
constexpr int ATT_KS = 272, ATT_VS = 320, ATT_KB = 64 * ATT_KS, ATT_VB = 64 * ATT_VS, ATT_STAGE = ATT_KB + ATT_VB;
__device__ __forceinline__ void attn_tile_of(int t, int ntw, int nb_lo, int qb, int b, int& krow0, int& mtype, int& th) {
    if (t < ntw) { const int nb = nb_lo + (t >> 1); th = t & 1; krow0 = b * SEQ + nb * 128 + 64 * th; mtype = nb < qb ? 1 : (nb > qb ? 2 : 0); }
    else { krow0 = ML + b * CTXL + 64 * (t - ntw); mtype = 0; th = 0; }
}
__device__ __forceinline__ void ph_attn(Frame& F) {
    const bf16* Q = (const bf16*)(F.ws + WS_Q); const bf16* Kg = (const bf16*)(F.ws + WS_K); const bf16* Vg = (const bf16*)(F.ws + WS_V); bf16* O = (bf16*)(F.ws + WS_O);
    const float* sink = F.in[I_SINK];
    const int lane = F.lane, w = F.wave, r32 = lane & 31, hi = lane >> 5, tid = F.tid;
    LAS unsigned char* lds = F.lds;
    const int vtr_base = (4 * hi + ((lane & 15) >> 2)) * ATT_VS + (16 * ((lane >> 4) & 1) + 4 * (lane & 3)) * 2;
#define ATT_UNIT(uid_, b_, kvh_, hp_, qb_, nb_lo_, ntw_) do { const int v2_ = (uid_) & 255, s_ = (uid_) >> 8, combo_ = v2_ >> 1, half_ = v2_ & 1; \
        b_ = combo_ >> 3; kvh_ = (combo_ >> 1) & 3; hp_ = combo_ & 1; qb_ = s_ < 8 ? half_ * 8 + s_ : 16 + half_; nb_lo_ = 0; ntw_ = 0; \
        if (qb_ < 16) { nb_lo_ = qb_ > 0 ? qb_ - 1 : 0; const int nb_hi_ = qb_ < 15 ? qb_ + 1 : 15; ntw_ = 2 * (nb_hi_ - nb_lo_ + 1); } } while (0)
#define ATT_QROW(b_, qb_) ((qb_) < 16 ? (b_) * SEQ + (qb_) * 128 + qr0 + r32 : ML + (b_) * CTXL + ((qb_) - 16) * 128 + qr0 + r32)
    const int qr0 = 32 * (w & 3), srow0 = tid >> 4, sc = tid & 15;
    bf16x8 qn[8]; u32x4 stk[2], stv[2]; bool pref = false;
    for (int uid = F.vcu; uid < 2304; uid += F.G) {
        int b, kvh, hp, qb, nb_lo, ntw; ATT_UNIT(uid, b, kvh, hp, qb, nb_lo, ntw);
        const int head = 4 * kvh + 2 * hp + (w >> 2);
        const int qrow = ATT_QROW(b, qb);
        const int NT = ntw + 4;
        bf16x8 qf[8];
        int krow0, mtype, th;
        attn_tile_of(0, ntw, nb_lo, qb, b, krow0, mtype, th);
        if (!pref) {
#pragma unroll
            for (int ks = 0; ks < 8; ++ks) qf[ks] = *(const bf16x8*)(Q + (size_t)qrow * DM + head * 128 + 16 * ks + 8 * hi);
#pragma unroll
            for (int i = 0; i < 2; ++i) { const size_t g = (size_t)(krow0 + srow0 + 32 * i) * 512 + kvh * 128 + 8 * sc; stk[i] = *(const u32x4*)(Kg + g); stv[i] = *(const u32x4*)(Vg + g); }
        } else {
#pragma unroll
            for (int ks = 0; ks < 8; ++ks) qf[ks] = qn[ks];
        }
        float m_run = sink[head] * LOG2E, l_run = 1.f;
        f32x16 ot[4];
#pragma unroll
        for (int d = 0; d < 4; ++d)
#pragma unroll
            for (int r = 0; r < 16; ++r) ot[d][r] = 0.f;
        __syncthreads();
#pragma unroll
        for (int i = 0; i < 2; ++i) { *(LAS u32x4*)(lds + (srow0 + 32 * i) * ATT_KS + 16 * sc) = stk[i]; *(LAS u32x4*)(lds + ATT_KB + (srow0 + 32 * i) * ATT_VS + 16 * sc) = stv[i]; }
        __syncthreads();
        for (int t = 0; t < NT; ++t) {
            LAS unsigned char* kb = lds + (t & 1) * ATT_STAGE; LAS unsigned char* vb = kb + ATT_KB;
            int krow1, mtype1, th1;
            if (t + 1 < NT) { attn_tile_of(t + 1, ntw, nb_lo, qb, b, krow1, mtype1, th1);
#pragma unroll
                for (int i = 0; i < 2; ++i) { const size_t g = (size_t)(krow1 + srow0 + 32 * i) * 512 + kvh * 128 + 8 * sc; stk[i] = *(const u32x4*)(Kg + g); stv[i] = *(const u32x4*)(Vg + g); } }
            else { pref = uid + F.G < 2304;
                if (pref) { int b2, kvh2, hp2, qb2, nbl2, ntw2; ATT_UNIT(uid + F.G, b2, kvh2, hp2, qb2, nbl2, ntw2); int kr2, mt2, th2; attn_tile_of(0, ntw2, nbl2, qb2, b2, kr2, mt2, th2);
                    const int head2 = 4 * kvh2 + 2 * hp2 + (w >> 2), qrow2 = ATT_QROW(b2, qb2);
#pragma unroll
                    for (int ks = 0; ks < 8; ++ks) qn[ks] = *(const bf16x8*)(Q + (size_t)qrow2 * DM + head2 * 128 + 16 * ks + 8 * hi);
#pragma unroll
                    for (int i = 0; i < 2; ++i) { const size_t g = (size_t)(kr2 + srow0 + 32 * i) * 512 + kvh2 * 128 + 8 * sc; stk[i] = *(const u32x4*)(Kg + g); stv[i] = *(const u32x4*)(Vg + g); } } }
            const bool act = !((mtype == 1 && th == 0 && (w & 3) >= 2) || (mtype == 2 && th == 1 && (w & 3) <= 1));
            if (act) {
            f32x16 p0, p1;
#pragma unroll
            for (int r = 0; r < 16; ++r) { p0[r] = 0.f; p1[r] = 0.f; }
#pragma unroll
            for (int ks = 0; ks < 8; ++ks) {
                const bf16x8 a0 = *(const LAS bf16x8*)(kb + r32 * ATT_KS + (16 * ks + 8 * hi) * 2);
                const bf16x8 a1 = *(const LAS bf16x8*)(kb + (32 + r32) * ATT_KS + (16 * ks + 8 * hi) * 2);
                p0 = MFMA32(a0, qf[ks], p0); p1 = MFMA32(a1, qf[ks], p1);
            }
            if (mtype == 1) { asm volatile("" ::: "memory");
                const int d = qr0 + r32 - 64 * th - 4 * hi; const float NEG = -__builtin_inff();
#pragma unroll
                for (int r = 0; r < 16; ++r) { const int c = (r & 3) + 8 * (r >> 2); p0[r] = (c >= d) ? p0[r] : NEG; p1[r] = (c + 32 >= d) ? p1[r] : NEG; }
            } else if (mtype == 2) { asm volatile("" ::: "memory");
                const int d = qr0 + r32 - 64 * th - 4 * hi; const float NEG = -__builtin_inff();
#pragma unroll
                for (int r = 0; r < 16; ++r) { const int c = (r & 3) + 8 * (r >> 2); p0[r] = (c <= d) ? p0[r] : NEG; p1[r] = (c + 32 <= d) ? p1[r] : NEG; }
            }
            float mx = p0[0];
#pragma unroll
            for (int r = 1; r < 16; ++r) mx = fmaxf(mx, p0[r]);
#pragma unroll
            for (int r = 0; r < 16; ++r) mx = fmaxf(mx, p1[r]);
            mx = fmaxf(mx, __shfl_xor(mx, 32));
            const float mn = fmaxf(m_run, mx), alpha = fexp2(m_run - mn); m_run = mn;
            float ps = 0.f;
#pragma unroll
            for (int r = 0; r < 16; ++r) { p0[r] = fexp2(p0[r] - mn); p1[r] = fexp2(p1[r] - mn); ps += p0[r] + p1[r]; }
            ps += __shfl_xor(ps, 32);
            l_run = l_run * alpha + ps;
            if (__any(alpha != 1.f)) {
#pragma unroll
            for (int d = 0; d < 4; ++d)
#pragma unroll
                for (int r = 0; r < 16; ++r) ot[d][r] *= alpha; }
#pragma unroll
            for (int s4 = 0; s4 < 4; ++s4) {
                u32x4 pw;
                if (s4 == 0) { pw.x = cvtpk(p0[0], p0[1]); pw.y = cvtpk(p0[2], p0[3]); pw.z = cvtpk(p0[4], p0[5]); pw.w = cvtpk(p0[6], p0[7]); }
                if (s4 == 1) { pw.x = cvtpk(p0[8], p0[9]); pw.y = cvtpk(p0[10], p0[11]); pw.z = cvtpk(p0[12], p0[13]); pw.w = cvtpk(p0[14], p0[15]); }
                if (s4 == 2) { pw.x = cvtpk(p1[0], p1[1]); pw.y = cvtpk(p1[2], p1[3]); pw.z = cvtpk(p1[4], p1[5]); pw.w = cvtpk(p1[6], p1[7]); }
                if (s4 == 3) { pw.x = cvtpk(p1[8], p1[9]); pw.y = cvtpk(p1[10], p1[11]); pw.z = cvtpk(p1[12], p1[13]); pw.w = cvtpk(p1[14], p1[15]); }
                const bf16x8 pf = __builtin_bit_cast(bf16x8, pw);
#pragma unroll
                for (int d = 0; d < 4; ++d) {
                    const s16x4 lo = tr_read(vb + vtr_base + 16 * s4 * ATT_VS + 64 * d), hi4 = tr_read(vb + vtr_base + (16 * s4 + 8) * ATT_VS + 64 * d);
                    ot[d] = MFMA32(cat8(lo, hi4), pf, ot[d]);
                }
            }
            }
            if (t + 1 < NT) {
                LAS unsigned char* kn = lds + ((t + 1) & 1) * ATT_STAGE;
#pragma unroll
                for (int i = 0; i < 2; ++i) { *(LAS u32x4*)(kn + (srow0 + 32 * i) * ATT_KS + 16 * sc) = stk[i]; *(LAS u32x4*)(kn + ATT_KB + (srow0 + 32 * i) * ATT_VS + 16 * sc) = stv[i]; }
                krow0 = krow1; mtype = mtype1; th = th1;
            }
            __syncthreads();
        }
        const float inv = 1.f / l_run;
        bf16* orow = O + (size_t)qrow * DM + head * 128 + 4 * hi;
#pragma unroll
        for (int d = 0; d < 4; ++d)
#pragma unroll
            for (int g = 0; g < 4; ++g) { u32x2 o; o.x = cvtpk(ot[d][4 * g] * inv, ot[d][4 * g + 1] * inv); o.y = cvtpk(ot[d][4 * g + 2] * inv, ot[d][4 * g + 3] * inv);
                *(u32x2*)(orow + 32 * d + 8 * g) = o; }
    }
    __syncthreads();
#undef ATT_UNIT
#undef ATT_QROW
}
constexpr size_t WS_QD = WS_VX, WS_KD = WS_VX + 128 * MiB, WS_DD = WS_VX + 272 * MiB;
constexpr int GP_TS = 80;
__device__ __forceinline__ void ph_gprep(Frame& F) {
    const bf16* GQ = (const bf16*)(F.ws + WS_GQ); const bf16* GK = (const bf16*)(F.ws + WS_GK); const float* GU = (const float*)(F.ws + WS_GU);
    bf16* QD = (bf16*)(F.ws + WS_QD); bf16* KD = (bf16*)(F.ws + WS_KD); float* DD = (float*)(F.ws + WS_DD);
    const float* gw2 = F.in[I_GW2]; const float* gbp = F.in[I_GB];
    const int lane = F.lane, r32 = lane & 31, hi = lane >> 5;
    LAS unsigned char* KT = F.lds + F.wave * (4 * 32 * GP_TS); LAS unsigned char* QT = KT + 2 * 32 * GP_TS;
    const int gw = F.vcu * NWAVES + F.wave, NGW = F.G * NWAVES;
    for (int combo = gw & 31, part = gw >> 5, nparts = NGW >> 5; part < nparts && nparts > 0; part = nparts) {
        const int dir = combo >> 4, c0 = 64 * (combo & 15), tl = dir ? 0 : 31;
        u32x4 ph[2], pl[2]; float bias[2];
#pragma unroll
        for (int c = 0; c < 2; ++c) { float wv[8]; bias[c] = gbp[dir * 1024 + c0 + 32 * c + r32];
#pragma unroll
            for (int j = 0; j < 8; ++j) wv[j] = gw2[((size_t)dir * 16 + 8 * hi + j) * 1024 + c0 + 32 * c + r32];
#pragma unroll
            for (int j = 0; j < 4; ++j) { const unsigned hw = cvtpk(wv[2 * j], wv[2 * j + 1]); ph[c][j] = hw; pl[c][j] = cvtpk(wv[2 * j] - bflo(hw), wv[2 * j + 1] - bfhi(hw)); } }
        u32x4 lf0, lf1;
#pragma unroll
        for (int j = 0; j < 4; ++j) {
            const int sa = 8 * ((2 * j) >> 2) + 4 * hi + ((2 * j) & 3), sb2 = sa + 1;
            const bool a0 = dir ? (sa >= r32) : (sa <= r32), a1 = dir ? (sb2 >= r32) : (sb2 <= r32), c0b = dir ? (sa + 16 >= r32) : (sa + 16 <= r32), c1 = dir ? (sb2 + 16 >= r32) : (sb2 + 16 <= r32);
            lf0[j] = (a0 ? 0u : 0xBF80u) | (a1 ? 0u : 0xBF800000u); lf1[j] = (c0b ? 0u : 0xBF80u) | (c1 ? 0u : 0xBF800000u); }
        const u32x4 onesf = {0x3F803F80u, 0x3F803F80u, 0x3F803F80u, 0x3F803F80u};
        const int srow = lane >> 3, spc = lane & 7;
        const unsigned goff = (unsigned)(srow * 2048 + c0 * 2 + spc * 16);
        const int toff = (spc >> 2) * (32 * GP_TS) + srow * GP_TS + (spc & 3) * 16;
        u32x4 nk[4], nq[4]; f32x4 nu0, nu1;
        constexpr int NCH = MA / 32;
#define GP_LOAD(ch_) do { const size_t rb_ = (size_t)(ch_) * 32; const char* kp_ = (const char*)GK + rb_ * 2048; _Pragma("unroll") for (int i_ = 0; i_ < 4; ++i_) nk[i_] = *(const u32x4*)(kp_ + goff + i_ * 8 * 2048); \
            if (rb_ < (size_t)ML) { const char* qp_ = (const char*)GQ + rb_ * 2048; _Pragma("unroll") for (int i_ = 0; i_ < 4; ++i_) nq[i_] = *(const u32x4*)(qp_ + goff + i_ * 8 * 2048); } \
            const float* up_ = GU + (rb_ + r32) * 32 + 16 * dir + 8 * hi; nu0 = *(const f32x4*)up_; nu1 = *(const f32x4*)(up_ + 4); } while (0)
        int ch = part;
        if (ch < NCH) GP_LOAD(ch);
#pragma unroll 1
        for (; ch < NCH; ch += nparts) {
            const int row0 = 32 * ch; const bool isctx = row0 >= ML;
#pragma unroll
            for (int i = 0; i < 4; ++i) *(LAS u32x4*)(KT + toff + i * 8 * GP_TS) = nk[i];
            if (!isctx) {
#pragma unroll
                for (int i = 0; i < 4; ++i) *(LAS u32x4*)(QT + toff + i * 8 * GP_TS) = nq[i]; }
            u32x4 uh, ul;
            { const float uu[8] = {nu0[0], nu0[1], nu0[2], nu0[3], nu1[0], nu1[1], nu1[2], nu1[3]};
#pragma unroll
              for (int j = 0; j < 4; ++j) { const unsigned hw = cvtpk(uu[2 * j], uu[2 * j + 1]); uh[j] = hw; ul[j] = cvtpk(uu[2 * j] - bflo(hw), uu[2 * j + 1] - bfhi(hw)); } }
            if (ch + nparts < NCH) GP_LOAD(ch + nparts);
            f32x16 pre[2], bb[2], bl[2];
#pragma unroll
            for (int c = 0; c < 2; ++c) {
#pragma unroll
                for (int r = 0; r < 16; ++r) pre[c][r] = 0.f;
                pre[c] = MFMA32(__builtin_bit_cast(bf16x8, uh), __builtin_bit_cast(bf16x8, ph[c]), pre[c]); pre[c] = MFMA32(__builtin_bit_cast(bf16x8, ul), __builtin_bit_cast(bf16x8, ph[c]), pre[c]);
                pre[c] = MFMA32(__builtin_bit_cast(bf16x8, uh), __builtin_bit_cast(bf16x8, pl[c]), pre[c]); }
#pragma unroll
            for (int c = 0; c < 2; ++c)
#pragma unroll
                for (int r = 0; r < 16; ++r) { const float p = pre[c][r] + bias[c];
                    pre[c][r] = (fminf(p, 0.f) - __builtin_amdgcn_logf(1.f + fexp2(-fabsf(p) * LOG2E)) * 0.6931471805599453f) * 0.0625f; }
#pragma unroll
            for (int c = 0; c < 2; ++c) {
#pragma unroll
                for (int r = 0; r < 16; ++r) { bb[c][r] = 0.f; bl[c][r] = 0.f; }
#pragma unroll
                for (int st = 0; st < 2; ++st) { u32x4 lh, ll;
#pragma unroll
                    for (int j = 0; j < 4; ++j) { const float a = pre[c][8 * st + 2 * j], cc = pre[c][8 * st + 2 * j + 1]; const unsigned hw = cvtpk(a, cc); lh[j] = hw; ll[j] = cvtpk(a - bflo(hw), cc - bfhi(hw)); }
                    const bf16x8 lf = __builtin_bit_cast(bf16x8, st ? lf1 : lf0);
                    bb[c] = MFMA32(__builtin_bit_cast(bf16x8, lh), lf, bb[c]); bb[c] = MFMA32(__builtin_bit_cast(bf16x8, ll), lf, bb[c]);
                    bl[c] = MFMA32(__builtin_bit_cast(bf16x8, lh), __builtin_bit_cast(bf16x8, onesf), bl[c]); bl[c] = MFMA32(__builtin_bit_cast(bf16x8, ll), __builtin_bit_cast(bf16x8, onesf), bl[c]); } }
            asm volatile("s_waitcnt lgkmcnt(0)" ::: "memory");
            const int pb = r32 * GP_TS + 8 * hi;
#pragma unroll
            for (int g = 0; g < 4; ++g)
#pragma unroll
              for (int c = 0; c < 2; ++c) { float e[4];
#pragma unroll
                for (int j = 0; j < 4; ++j) e[j] = bb[c][4 * g + j] * LOG2E;
                LAS u32x2* kp = (LAS u32x2*)(KT + c * (32 * GP_TS) + pb + 16 * g); const u32x2 kw = *kp; u32x2 ko;
                ko.x = cvtpk(bflo(kw.x) * fexp2(-e[0]), bfhi(kw.x) * fexp2(-e[1])); ko.y = cvtpk(bflo(kw.y) * fexp2(-e[2]), bfhi(kw.y) * fexp2(-e[3])); *kp = ko;
                if (!isctx) { LAS u32x2* qp = (LAS u32x2*)(QT + c * (32 * GP_TS) + pb + 16 * g); const u32x2 qw = *qp; u32x2 qo;
                    qo.x = cvtpk(bflo(qw.x) * fexp2(e[0]), bfhi(qw.x) * fexp2(e[1])); qo.y = cvtpk(bflo(qw.y) * fexp2(e[2]), bfhi(qw.y) * fexp2(e[3])); *qp = qo; } }
            if (r32 == tl) {
#pragma unroll
                for (int c = 0; c < 2; ++c)
#pragma unroll
                    for (int g = 0; g < 4; ++g) { f32x4 d;
#pragma unroll
                        for (int j = 0; j < 4; ++j) d[j] = fexp2(bl[c][4 * g + j] * LOG2E);
                        *(f32x4*)(DD + ((size_t)ch * 2 + dir) * 1024 + c0 + 32 * c + 8 * g + 4 * hi) = d; } }
            asm volatile("s_waitcnt lgkmcnt(0)" ::: "memory");
            { char* kq = (char*)KD + ((size_t)dir * MA + row0) * 2048;
#pragma unroll
              for (int i = 0; i < 4; ++i) *(u32x4*)(kq + goff + i * 8 * 2048) = *(const LAS u32x4*)(KT + toff + i * 8 * GP_TS); }
            if (!isctx) { char* qq = (char*)QD + ((size_t)dir * ML + row0) * 2048;
#pragma unroll
              for (int i = 0; i < 4; ++i) *(u32x4*)(qq + goff + i * 8 * 2048) = *(const LAS u32x4*)(QT + toff + i * 8 * GP_TS); }
            asm volatile("s_waitcnt lgkmcnt(0)" ::: "memory");
        }
#undef GP_LOAD
    }
    __syncthreads();
}

constexpr int SC_QS = 528, SC_KS = 576, SC_VS = 576, SC_AS = 80;
constexpr int SC_QI = 0, SC_KI = SC_QI + 32 * SC_QS, SC_VI = SC_KI + 32 * SC_KS, SC_DI = SC_VI + 32 * SC_VS, SC_BUF = SC_DI + 1024;
constexpr int SC_ATT = 2 * SC_BUF, SC_END = SC_ATT + 32 * SC_AS;
static_assert(SC_END <= MISC_OFF, "scan LDS");
struct ScanRaw { u32x4 q0, q1, k0, k1, v0, v1; f32x4 d; };
__device__ __forceinline__ void scan_chunk_pos(int ci, int dir, int b, bool& isctx, int& row0) {
    isctx = ci < 8; const int cc = isctx ? ci : ci - 8, nch = isctx ? 8 : 64, c = dir ? nch - 1 - cc : cc;
    row0 = isctx ? ML + b * CTXL + 32 * c : b * SEQ + 32 * c;
}
#define SC_BARRIER() do { asm volatile("s_waitcnt lgkmcnt(0)" ::: "memory"); __builtin_amdgcn_s_barrier(); asm volatile("" ::: "memory"); } while (0)
#define SC_ADDR(name, base, off) int name = (base) + (off); asm volatile("" : "+v"(name))
template <int ABL>
__device__ __forceinline__ void ph_scan_t(Frame& F) {
    const bf16* QD = (const bf16*)(F.ws + WS_QD); const bf16* KD = (const bf16*)(F.ws + WS_KD); const bf16* GV = (const bf16*)(F.ws + WS_GV); const float* DD = (const float*)(F.ws + WS_DD);
    bf16* OF = (bf16*)(F.ws + ((ABL & 256) ? WS_GQ : WS_HB)); bf16* OB = (bf16*)(F.ws + ((ABL & 256) ? WS_GQ : WS_OB));
    LAS unsigned char* lds = F.lds;
    const int w = F.wave;
    for (int uid = F.vcu; uid < 256; uid += F.G) {
    const int tid = F.wave * 64 + lane_id_v();
    const int lane = tid & 63, r32 = lane & 31, hi = lane >> 5, i16 = lane & 15, g16 = (lane >> 4) & 1;
    const int trq = i16 >> 2, trp = i16 & 3, pt = tid >> 4, cg = tid & 15;
    const int kwb = SC_KI + pt * SC_KS + cg * 32, qwb = SC_QI + pt * SC_QS + cg * 32, vwb = SC_VI + pt * SC_VS + cg * 32, dwb = SC_DI + lane * 16;
    const int kab = SC_KI + (16 * ((w >> 1) & 1) + i16) * SC_KS + 16 * (lane >> 4), qab = SC_QI + (16 * (w & 1) + i16) * SC_QS + 16 * (lane >> 4);
    const int atw = SC_ATT + (16 * (w & 1) + i16) * SC_AS + (16 * ((w >> 1) & 1) + 4 * (lane >> 4)) * 2;
    const int drb = SC_DI + 16 * hi, qrb = SC_QI + r32 * SC_QS + 8 * hi, vtb = SC_VI + (8 * hi + trq) * SC_VS + (32 * w + 16 * g16 + 4 * trp) * 2, ktb = SC_KI + (8 * hi + trq) * SC_KS + (16 * g16 + 4 * trp) * 2;
    const int arb = SC_ATT + r32 * SC_AS + 16 * hi;
        const int b = uid >> 4, h = (uid >> 2) & 3, dir = (uid >> 1) & 1, sl = uid & 1;
        bf16* Od = dir ? OB : OF;
        const bf16* Qd = QD + (size_t)dir * ML * 1024; const bf16* Kd = KD + (size_t)dir * MA * 1024;
        unsigned amask = 0u;
        { const int s0 = 16 * ((w >> 1) & 1) + 4 * (lane >> 4), tt = 16 * (w & 1) + i16;
#pragma unroll
          for (int j = 0; j < 4; ++j) amask |= ((dir ? (s0 + j >= tt) : (s0 + j <= tt)) ? 1u : 0u) << j; }
        asm volatile("" : "+v"(amask));
        f32x16 S[8];
#pragma unroll
        for (int k = 0; k < 8; ++k)
#pragma unroll
            for (int r = 0; r < 16; ++r) S[k][r] = 0.f;
        if constexpr (ABL != 0) {
#pragma unroll
            for (int k = 0; k < 8; ++k) asm volatile("" : "+v"(S[k]));
        }
        ScanRaw R;
        const unsigned koff = (unsigned)(pt * 2048 + (h * 256 + 16 * cg) * 2), voff = (unsigned)(pt * 4096 + (h * 512 + sl * 256 + 16 * cg) * 2), doff = (unsigned)((h * 256 + 4 * lane) * 4);
        const unsigned ooff = (unsigned)(r32 * 4096 + (h * 512 + sl * 256 + 32 * w + 4 * hi) * 2);
#define SCAN_LOAD(cj) do { bool ic_; int r0_; scan_chunk_pos((cj), dir, b, ic_, r0_); \
            const char* kb_ = (const char*)Kd + (size_t)r0_ * 2048; R.k0 = *(const u32x4*)(kb_ + koff); R.k1 = *(const u32x4*)(kb_ + koff + 16); \
            if (!ic_) { const char* qb_ = (const char*)Qd + (size_t)r0_ * 2048; R.q0 = *(const u32x4*)(qb_ + koff); R.q1 = *(const u32x4*)(qb_ + koff + 16); } \
            const char* vb_ = (const char*)GV + (size_t)r0_ * 4096; R.v0 = *(const u32x4*)(vb_ + voff); R.v1 = *(const u32x4*)(vb_ + voff + 16); \
            if (w == 0) R.d = *(const f32x4*)((const char*)DD + ((size_t)(r0_ >> 5) * 2 + dir) * 4096 + doff); } while (0)
#define SCAN_WRITE(cj) do { bool ic_; int r0_; scan_chunk_pos((cj), dir, b, ic_, r0_); (void)r0_; const int ibo_ = ((cj) & 1) * SC_BUF; \
            SC_ADDR(ka_, kwb, ibo_); *(LAS u32x4*)(lds + ka_) = R.k0; *(LAS u32x4*)(lds + ka_ + 16) = R.k1; \
            if (!ic_) { SC_ADDR(qa_, qwb, ibo_); *(LAS u32x4*)(lds + qa_) = R.q0; *(LAS u32x4*)(lds + qa_ + 16) = R.q1; } \
            SC_ADDR(va_, vwb, ibo_); *(LAS u32x4*)(lds + va_) = R.v0; *(LAS u32x4*)(lds + va_ + 16) = R.v1; \
            if (w == 0) { SC_ADDR(da_, dwb, ibo_); *(LAS f32x4*)(lds + da_) = R.d; } } while (0)

        __syncthreads();
        SCAN_LOAD(0); SCAN_WRITE(0); SCAN_LOAD(1);
        __syncthreads();
#pragma unroll 1
        for (int ci = 0; ci < 72; ++ci) {
            bool isctx; int row0; scan_chunk_pos(ci, dir, b, isctx, row0);
            const int ibo = (ci & 1) * SC_BUF;
            if (!(ABL & 32)) { if (ci + 1 < 72) { SCAN_WRITE(ci + 1); } }
            if (!(ABL & 16)) { if (ci + 2 < 72) { SCAN_LOAD(ci + 2); } }
            if (!(ABL & 8) && !isctx && w < 4) {
                f32x4 a4 = {0.f, 0.f, 0.f, 0.f}; SC_ADDR(ka, kab, ibo); SC_ADDR(qa, qab, ibo);
#pragma unroll
                for (int k8 = 0; k8 < 8; ++k8) { const bf16x8 kf = *(const LAS bf16x8*)(lds + ka + 64 * k8); const bf16x8 qf = *(const LAS bf16x8*)(lds + qa + 64 * k8); a4 = MFMA16(kf, qf, a4); }
#pragma unroll
                for (int j = 0; j < 4; ++j) a4[j] = ((amask >> j) & 1u) ? a4[j] : 0.f;
                u32x2 o; o.x = cvtpk(a4[0], a4[1]); o.y = cvtpk(a4[2], a4[3]);
                *(LAS u32x2*)(lds + atw) = o;
            }
            if constexpr (!(ABL & 1)) { SC_ADDR(da, drb, ibo);
#pragma unroll
              for (int k = 0; k < 8; ++k)
#pragma unroll
                for (int g = 0; g < 4; ++g) { const f32x4 d4 = *(const LAS f32x4*)(lds + da + (32 * k + 8 * g) * 4);
#pragma unroll
                    for (int j = 0; j < 4; ++j) S[k][4 * g + j] *= d4[j]; } }
            f32x16 ot;
#pragma unroll
            for (int r = 0; r < 16; ++r) ot[r] = 0.f;
            if (!(ABL & 2) && !isctx) {
                SC_ADDR(qa, qrb, ibo);
#pragma unroll
                for (int k = 0; k < 8; ++k)
#pragma unroll
                    for (int s2 = 0; s2 < 2; ++s2) {
                        u32x4 sw; sw.x = cvtpk(S[k][8 * s2], S[k][8 * s2 + 1]); sw.y = cvtpk(S[k][8 * s2 + 2], S[k][8 * s2 + 3]); sw.z = cvtpk(S[k][8 * s2 + 4], S[k][8 * s2 + 5]); sw.w = cvtpk(S[k][8 * s2 + 6], S[k][8 * s2 + 7]);
                        const u32x2 qx = *(const LAS u32x2*)(lds + qa + (32 * k + 16 * s2) * 2), qc = *(const LAS u32x2*)(lds + qa + (32 * k + 16 * s2) * 2 + 16);
                        u32x4 qw; qw.x = qx.x; qw.y = qx.y; qw.z = qc.x; qw.w = qc.y;
                        ot = MFMA32(__builtin_bit_cast(bf16x8, sw), __builtin_bit_cast(bf16x8, qw), ot);
                    }
            }
            if constexpr (!(ABL & 128)) SC_BARRIER();
            bf16x8 vf[2];
            { SC_ADDR(va, vtb, ibo);
#pragma unroll
              for (int ts = 0; ts < 2; ++ts) vf[ts] = cat8(tr_read(lds + va + 16 * ts * SC_VS), tr_read(lds + va + (16 * ts + 4) * SC_VS)); }
            if (!(ABL & 64) && !isctx) {
#pragma unroll
                for (int ts = 0; ts < 2; ++ts) { const bf16x8 af = *(const LAS bf16x8*)(lds + arb + 32 * ts); ot = MFMA32(vf[ts], af, ot); }
                char* op = (char*)Od + (size_t)row0 * 4096;
#pragma unroll
                for (int g = 0; g < 4; ++g) { u32x2 o; o.x = cvtpk(ot[4 * g], ot[4 * g + 1]); o.y = cvtpk(ot[4 * g + 2], ot[4 * g + 3]); *(u32x2*)(op + ooff + 16 * g) = o; }
            }
            if ((ABL & 64) && !(ABL & 2) && !isctx) { asm volatile("" :: "v"(ot)); }
            if constexpr (!(ABL & 4)) { SC_ADDR(ka, ktb, ibo);
#pragma unroll
              for (int k = 0; k < 8; ++k)
#pragma unroll
                for (int ts = 0; ts < 2; ++ts) S[k] = MFMA32(cat8(tr_read(lds + ka + 16 * ts * SC_KS + 64 * k), tr_read(lds + ka + (16 * ts + 4) * SC_KS + 64 * k)), vf[ts], S[k]); }
            if constexpr (!(ABL & 128)) SC_BARRIER();
        }
        if constexpr (ABL != 0) {
#pragma unroll
            for (int k = 0; k < 8; ++k) asm volatile("" :: "v"(S[k]));
        }
#undef SCAN_LOAD
#undef SCAN_WRITE
    }
    __syncthreads();
}
__device__ __forceinline__ void ph_scan(Frame& F) {
    ph_scan_t<0>(F);
#ifdef SCAN_ABL
#ifndef SCAN_ABL_REP
#define SCAN_ABL_REP 1
#endif
#pragma unroll 1
    for (int rep = 0; rep < SCAN_ABL_REP; ++rep) ph_scan_t<SCAN_ABL>(F);
#endif
}
constexpr int N_PHASES = 22;
#define TAIL_PHASES(l, pb) \
    if (IN(pb)) REP(pb) { PH_BEGIN(); \
        ProbDense P; P.K = DM; P.A = (const bf16*)(ws + (l ? WS_A2 : WS_O)); P.Bt = (const bf16*)(ws + (l ? WS_WO2 : WS_WO)); P.S.init((l ? ML : MA) / 256, DM / 256, F.G, (int)blockIdx.x); \
        EpiWOut E{(bf16*)(ws + WS_VX), l ? (const float*)nullptr : F.in[I_X], F.in[I_CTX], (const bf16*)F.out, (const float*)(ws + WS_MODS) + (size_t)l * 17 * MODN}; \
        pg8::gemm_phase<EpiWOut, ProbDense, true>(F.lds, P, E, F.wave); \
        if (l == 0) { const int c0 = tail_first(P.S.nwg, F.G), c = (int)blockIdx.x; PH_BEGIN();     \
          if (c0 >= F.G) conv_static(F, 1, CV_E0_HEAD, CV_MOE_ITEMS, F.G, c); else if (c >= c0) conv_static(F, 1, CV_E0_HEAD, CV_MOE_ITEMS, F.G - c0, c - c0); } \
    } SEAM(pb); \
    if (IN(pb + 1)) REP(pb + 1) { PH_BEGIN(); ph_ln1(F, l); } SEAM(pb + 1); \
    if (IN(pb + 2)) REP(pb + 2) { PH_BEGIN(); skinny_gemm<3>(F, (const bf16*)(ws + WS_HB), (const bf16*)(ws + WS_WR) + (size_t)l * 256 * DM, (float*)(ws + WS_LOG), 256, l ? ML : MA); \
        PH_BEGIN(); ph_topk(F, l); } SEAM(pb + 2);     \
    if (IN(pb + 4)) REP(pb + 4) { PH_BEGIN(); \
        const MoeTables Tb = moe_tables(F, l); \
        ProbGU P; P.K = DM; P.A = (const bf16*)(ws + WS_HB); P.Bt = (const bf16*)(ws + WS_WGU); P.list = (const unsigned*)(ws + WS_LIST); P.Tb = Tb; P.G = F.G; P.c = (int)blockIdx.x; \
        EpiGU E{(bf16*)(ws + WS_HID)}; \
        pg8::gemm_phase<EpiGU, ProbGU, true>(F.lds, P, E, F.wave); \
    } SEAM(pb + 4); \
    if (IN(pb + 5)) REP(pb + 5) { PH_BEGIN(); \
        const MoeTables Tb = moe_tables(F, l); \
        ProbDown P; P.K = MOEH; P.A = (const bf16*)(ws + WS_HID); P.Bt = (const bf16*)(ws + WS_WD); P.Tb = Tb; P.G = F.G; P.c = (int)blockIdx.x; \
        EpiDown E{(bf16*)(ws + WS_Y2), (const unsigned*)(ws + WS_LIST), (const float*)(ws + WS_WLIST)}; \
        pg8::gemm_phase<EpiDown, ProbDown, true>(F.lds, P, E, F.wave); \
    } SEAM(pb + 5); \
    if (IN(pb + 6)) REP(pb + 6) { PH_BEGIN(); ph_ln2(F, l); if (l == 0) ph_conv_moe(F, 1); } SEAM(pb + 6);

__device__ __forceinline__ int tail_first(int n, int G) { return n - ((n + G - 1) / G - 1) * G; }
#define KARGS_DECL const float* i0, const float* i1, const float* i2, const float* i3, const float* i4, const float* i5, const float* i6, const float* i7, const float* i8, const float* i9, const float* i10, const float* i11, \
    const float* i12, const float* i13, const float* i14, const float* i15, const float* i16, const float* i17, const float* i18, const float* i19, const float* i20, const float* i21, const float* i22, const float* i23, \
    float* outp, unsigned char* wsp, int ph_lo, int ph_hi
__global__ void __launch_bounds__(NTHREADS, 2) fwd_kernel(KARGS_DECL) {
    const float* const inarr[24] = {i0, i1, i2, i3, i4, i5, i6, i7, i8, i9, i10, i11, i12, i13, i14, i15, i16, i17, i18, i19, i20, i21, i22, i23};
    extern __shared__ __attribute__((aligned(16))) unsigned char lds_raw[];
    Frame F;
    F.lds = (LAS unsigned char*)lds_raw;
    F.tid = threadIdx.x; F.lane = F.tid & 63; F.wave = __builtin_amdgcn_readfirstlane(F.tid >> 6);
    F.G = gridDim.x; { const int bx = blockIdx.x; F.vcu = (F.G % 8 == 0) ? (bx % 8) * (F.G / 8) + bx / 8 : bx; }
    F.in.p = inarr; F.out = outp; F.ws = wsp; F.ctl = (unsigned*)(F.ws + WS_CTL);
    for (int u = F.tid; u < (LDS_BYTES - MISC_OFF) / 4; u += NTHREADS) ((LAS unsigned*)(F.lds + MISC_OFF))[u] = 0u;
    __syncthreads();
    const int lo = ph_lo, hi = ph_hi;
    XcdBarrier bar; bar.bar = F.ctl + CW_BAR; bar.x = 0; bar.st = nullptr;
    if (hi - lo > 1) bar = xcd_barrier_post(F.ctl + CW_BAR, (volatile LAS unsigned*)(F.lds + MISC_OFF + 32), F.tid);
#ifdef ONLY_SET
#define IN(k) (((ONLY_SET >> (k)) & 1) && lo <= (k) && (k) < hi)
#else
#define IN(k) (lo <= (k) && (k) < hi)
#endif
#ifndef DUP_MASK
#define DUP_MASK 0
#endif
#ifndef DUP_REPS
#define DUP_REPS 2
#endif
#define REP(k) for (int rep_ = 0; rep_ < ((((DUP_MASK) >> (k)) & 1) ? DUP_REPS : 1); ++rep_)
#define PH_BEGIN() do { F.tid = F.wave * 64 + lane_id(); asm volatile("" : "+v"(F.tid)); F.lane = F.tid & 63; } while (0)
#ifdef EXTRA_BAR
#define SEAM(k) do { if (IN(k) && IN((k) + 1)) { xcd_barrier(bar, F.wave * 64 + lane_id()); if ((k) & 1) { xcd_barrier(bar, F.wave * 64 + lane_id()); xcd_barrier(bar, F.wave * 64 + lane_id()); } } } while (0)
#else
#define SEAM(k) do { if (IN(k) && IN((k) + 1)) xcd_barrier(bar, F.wave * 64 + lane_id()); } while (0)
#endif
    unsigned char* ws = F.ws;
    if (IN(0)) REP(0) { PH_BEGIN(); ph_mods(F); ph_conv0(F); } SEAM(0);
    if (IN(1)) REP(1) { PH_BEGIN(); ph_mod0(F); } SEAM(1);
    if (IN(2)) REP(2) { PH_BEGIN();
        ProbDense P; P.K = DM; P.A = (const bf16*)(ws + WS_HB); P.Bt = (const bf16*)(ws + WS_WQKV); P.S.init(MA / 256, NQKV / 256, F.G, (int)blockIdx.x);
        EpiQKV E{(bf16*)(ws + WS_Q), (bf16*)(ws + WS_K), (bf16*)(ws + WS_V), (const float*)(ws + WS_ROPE)};
        pg8::gemm_phase<EpiQKV, ProbDense, true>(F.lds, P, E, F.wave);
        { const int c0 = tail_first(P.S.nwg, F.G), c = (int)blockIdx.x; PH_BEGIN();
          if (c0 >= F.G) conv_static(F, 0, 0, CQ_DENSE, F.G, c); else if (c >= c0) conv_static(F, 0, 0, CQ_DENSE, F.G - c0, c - c0); }
    } SEAM(2);
    if (IN(3)) REP(3) { PH_BEGIN(); ph_attn(F); } SEAM(3);
    TAIL_PHASES(0, 4)
    if (IN(11)) REP(11) { PH_BEGIN();
        ProbProj P; P.K = DM; P.A = (const bf16*)(ws + WS_HB); P.Bt = (const bf16*)(ws + WS_WIN); P.S.init(ML / 256, 24, F.G, (int)blockIdx.x); P.G = F.G; P.c = (int)blockIdx.x;
        EpiProj E{(bf16*)(ws + WS_GQ), (bf16*)(ws + WS_GK), (bf16*)(ws + WS_GV), (bf16*)(ws + WS_GR), (float*)(ws + WS_GU)};
        pg8::gemm_phase<EpiProj, ProbProj, true>(F.lds, P, E, F.wave);
        { const int nun = (ML / 256) * 24 + 16 * 12, c0 = nun - ((nun + F.G - 1) / F.G - 1) * F.G, c = (int)blockIdx.x;
          PH_BEGIN();
          if (c0 >= F.G) skinny_gemm<1>(F, (const bf16*)(ws + WS_HB), (const bf16*)(ws + WS_WIN) + (size_t)6144 * DM, (float*)(ws + WS_GU), 32, MA);
          else if (c >= c0) skinny_gemm<1>(F, (const bf16*)(ws + WS_HB), (const bf16*)(ws + WS_WIN) + (size_t)6144 * DM, (float*)(ws + WS_GU), 32, MA, F.G - c0, c - c0); }
    } SEAM(11);
    if (IN(12)) REP(12) { PH_BEGIN(); ph_gprep(F); } SEAM(12);
    if (IN(13)) REP(13) { PH_BEGIN(); ph_scan(F); } SEAM(13);
    if (IN(14)) REP(14) { PH_BEGIN(); ph_readout(F); } SEAM(14);
    TAIL_PHASES(1, 15)
#undef IN
#undef SEAM
}

extern "C" void kernel_launch(void* const* d_in, const int* in_sizes, int n_in, void* d_out, int out_size, void* d_ws, size_t ws_size, hipStream_t stream) {
    static int grid = 0;
    if (grid == 0) {
        if (n_in != 24 || out_size != ML * DM || ws_size < WS_END) { fprintf(stderr, "kernel_launch: unexpected problem (n_in %d out %d ws %zu need %zu)\n", n_in, out_size, ws_size, (size_t)WS_END); grid = -1; return; }
        int dev = 0, cus = 0, per_cu = 0;
        if (hipGetDevice(&dev) != hipSuccess || hipDeviceGetAttribute(&cus, hipDeviceAttributeMultiprocessorCount, dev) != hipSuccess) { grid = -1; return; }
        if (hipFuncSetAttribute((const void*)fwd_kernel, hipFuncAttributeMaxDynamicSharedMemorySize, LDS_BYTES) != hipSuccess) { fprintf(stderr, "kernel_launch: hipFuncSetAttribute failed\n"); grid = -1; return; }
        if (hipOccupancyMaxActiveBlocksPerMultiprocessor(&per_cu, (const void*)fwd_kernel, NTHREADS, LDS_BYTES) != hipSuccess || per_cu < 1) { fprintf(stderr, "kernel_launch: occupancy query says %d\n", per_cu); }
        (void)hipGetLastError();
        grid = cus;
    }
    if (grid < 0) return;
    (void)hipMemsetAsync((char*)d_ws + WS_CTL, 0, CTL_ZERO_BYTES, stream);
    const float* in[24];
    for (int i = 0; i < 24; ++i) in[i] = (const float*)d_in[i];
#define KARGS(lo_, hi_) in[0], in[1], in[2], in[3], in[4], in[5], in[6], in[7], in[8], in[9], in[10], in[11], in[12], in[13], in[14], in[15], in[16], in[17], in[18], in[19], in[20], in[21], in[22], in[23], (float*)d_out, (unsigned char*)d_ws, (lo_), (hi_)
#if MK_FUSED
    hipLaunchKernelGGL(fwd_kernel, dim3(grid), dim3(NTHREADS), LDS_BYTES, stream, KARGS(0, N_PHASES));
#else
    for (int p = 0; p < N_PHASES; ++p) hipLaunchKernelGGL(fwd_kernel, dim3(grid), dim3(NTHREADS), LDS_BYTES, stream, KARGS(p, p + 1));
#endif
}
```
